# Optimizing an MI355X kernel written in HIP

```python
import math
import jax
import jax.numpy as jnp
from jax import lax
import numpy as np


D_MODEL = 1024
BATCH = 2
SEQ = 8192
DEPTH = 4
DEC_BATCH = 8
DEC_SEQ = 32
PAST_LEN = 1024

CHUNK = 64
N_MIXERS = 3
N_A = (DEPTH + 2) // 3
N_B = (DEPTH + 1) // 3
N_C = DEPTH // 3
D_FF = 2816
D_RNN = 1280
LRU_BLOCKS = 16
LRU_BS = D_RNN // LRU_BLOCKS
CONV_W = 4
LRU_C = 8.0
POOL_WINDOWS = (2, 4, 8, 16)
POOL_GROUPS = 4
POOL_GW = D_MODEL // POOL_GROUPS
POOL_HIST = 15
N_HEADS = 8
HEAD_DIM = D_MODEL // (2 * N_HEADS)
NUM_BUCKETS = 32
MAX_DISTANCE = 128
QBLOCK = 128
EPS = 1e-6
NEG_INF = -1e30

kernel_name = 'hybrid_streaming_encoder_step'


def rmsnorm(x, g):
    x32 = x.astype(jnp.float32)
    y = x32 * lax.rsqrt(jnp.mean(x32 * x32, axis=-1, keepdims=True) + EPS)
    return (y * g.astype(jnp.float32)).astype(x.dtype)


def modulate(x, g, shift, scale):
    return rmsnorm(x, g) * (1 + scale[:, None, :]) + shift[:, None, :]


def adaln(c, w, b):
    return jnp.split(jax.nn.silu(c) @ w + b, 9, axis=-1)


def swiglu(u, w_in, w_out):
    a, b = jnp.split(u @ w_in, 2, axis=-1)
    return (jax.nn.silu(a) * b) @ w_out


def ffn_half(x, shift, scale, gate, g, w_in, w_out):
    u = modulate(x, g, shift, scale)
    return x + 0.5 * gate[:, None, :] * swiglu(u, w_in, w_out)


def causal_dwconv(x, buf, w, b):
    T = x.shape[1]
    xp = jnp.concatenate([buf.astype(x.dtype), x], axis=1)
    y = b + w[0] * xp[:, 0:T]
    for k in range(1, CONV_W):
        y = y + w[k] * xp[:, k:k + T]
    return y, xp[:, -(CONV_W - 1):]


def rg_lru_mixer(u, conv_buf, h0, w_in, conv_w, conv_b, ga_w, ga_b, gx_w, gx_b, lam, w_out):
    B, T, _ = u.shape
    gate_br, x_br = jnp.split(u @ w_in, 2, axis=-1)
    xc, new_buf = causal_dwconv(x_br, conv_buf, conv_w, conv_b)
    xb = xc.reshape(B, T, LRU_BLOCKS, LRU_BS)
    r = jax.nn.sigmoid(jnp.einsum('bthi,hij->bthj', xb, ga_w).reshape(B, T, D_RNN) + ga_b)
    i = jax.nn.sigmoid(jnp.einsum('bthi,hij->bthj', xb, gx_w).reshape(B, T, D_RNN) + gx_b)
    log_a = (-LRU_C * r.astype(jnp.float32)) * jax.nn.softplus(-lam.astype(jnp.float32))
    a = jnp.exp(log_a)
    b_in = jnp.sqrt(-jnp.expm1(2.0 * log_a)) * (i * xc).astype(jnp.float32)
    b_in = b_in.at[:, 0].add(a[:, 0] * h0.astype(jnp.float32))

    def combine(left, right):
        a1, b1 = left
        a2, b2 = right
        return a1 * a2, a2 * b1 + b2

    _, h = lax.associative_scan(combine, (a, b_in), axis=1)
    y = (jax.nn.gelu(gate_br) * h.astype(u.dtype)) @ w_out
    return y, new_buf, h[:, -1].astype(h0.dtype)


def pool_mixer(u_ext, n_new, w, b, scale):
    B, L, _ = u_ext.shape
    u32 = u_ext.astype(jnp.float32)
    cs = jnp.concatenate([jnp.zeros((B, 1, D_MODEL), jnp.float32), jnp.cumsum(u32, axis=1)], axis=1)
    t = jnp.arange(L - n_new, L)
    outs = []
    for g, wnd in enumerate(POOL_WINDOWS):
        sl = slice(g * POOL_GW, (g + 1) * POOL_GW)
        lo = jnp.maximum(t + 1 - wnd, 0)
        cnt = jnp.minimum(t + 1, wnd).astype(jnp.float32)
        mean = (cs[:, t + 1, sl] - cs[:, lo, sl]) / cnt[None, :, None]
        d = (mean - u32[:, t, sl]).astype(u_ext.dtype)
        outs.append(jnp.einsum('btc,cd->btd', d, w[g]))
    y = jnp.concatenate(outs, axis=-1) + b
    return (y * scale).astype(u_ext.dtype)


def t5_bucket(rel):
    nb = NUM_BUCKETS // 2
    max_exact = nb // 2
    ret = jnp.where(rel > 0, nb, 0)
    n = jnp.abs(rel)
    nf = jnp.maximum(n, 1).astype(jnp.float32)
    large = max_exact + (jnp.log(nf / max_exact) / math.log(MAX_DISTANCE / max_exact)
                         * (nb - max_exact)).astype(jnp.int32)
    large = jnp.minimum(large, nb - 1)
    return ret + jnp.where(n < max_exact, n, large)


def diff_lambda(lam_p, lam_init):
    lp = lam_p.astype(jnp.float32)
    return jnp.exp(jnp.sum(lp[0] * lp[1])) - jnp.exp(jnp.sum(lp[2] * lp[3])) + lam_init


def diff_attn_qkv(u, w_in, q_g, k_g):
    B, T, _ = u.shape
    q, k, v = jnp.split(u @ w_in, 3, axis=-1)
    q = rmsnorm(q.reshape(B, T, N_HEADS, 2, HEAD_DIM), q_g)
    k = rmsnorm(k.reshape(B, T, N_HEADS, 2, HEAD_DIM), k_g)
    v = v.reshape(B, T, N_HEADS, 2 * HEAD_DIM)
    return q, k, v


def diff_attn_core(q, k, v, q_pos, k_pos, rel_bias, lam):
    s = jnp.einsum('bqhcd,bkhcd->bchqk', q.astype(jnp.float32), k.astype(jnp.float32)) * (HEAD_DIM ** -0.5)
    bias = jnp.transpose(rel_bias.astype(jnp.float32)[t5_bucket(k_pos[None, :] - q_pos[:, None])], (2, 0, 1))
    mask = (k_pos[None, :] // CHUNK) <= (q_pos[:, None] // CHUNK)
    s = jnp.where(mask, s + bias, NEG_INF)
    p = jax.nn.softmax(s, axis=-1)
    pd = p[:, 0] - lam * p[:, 1]
    return jnp.einsum('bhqk,bkhd->bqhd', pd.astype(v.dtype), v)


def diff_attn_out(o, sub_g, lam_init, w_out):
    B, T = o.shape[:2]
    o = rmsnorm(o, sub_g) * (1.0 - lam_init)
    return o.reshape(B, T, D_MODEL) @ w_out


def diff_attn_prompt(u, w_in, q_g, k_g, sub_g, w_out, rel_bias, lam, lam_init):
    B, S, _ = u.shape
    q, k, v = diff_attn_qkv(u, w_in, q_g, k_g)
    pos = jnp.arange(S)

    def block(i):
        start = i * QBLOCK
        qb = lax.dynamic_slice_in_dim(q, start, QBLOCK, axis=1)
        return diff_attn_core(qb, k, v, start + jnp.arange(QBLOCK), pos, rel_bias, lam)

    o = lax.map(block, jnp.arange(S // QBLOCK))
    o = jnp.moveaxis(o, 0, 1).reshape(B, S, N_HEADS, 2 * HEAD_DIM)
    y = diff_attn_out(o, sub_g, lam_init, w_out)
    return y, k.reshape(B, S, N_HEADS, 2 * HEAD_DIM), v


def diff_attn_sample(u, ck, cv, w_in, q_g, k_g, sub_g, w_out, rel_bias, lam, lam_init):
    B, T, _ = u.shape
    P = ck.shape[1]
    q, k, v = diff_attn_qkv(u, w_in, q_g, k_g)
    kf = jnp.concatenate([ck.astype(k.dtype).reshape(B, P, N_HEADS, 2, HEAD_DIM), k], axis=1)
    vf = jnp.concatenate([cv.astype(v.dtype), v], axis=1)
    o = diff_attn_core(q, kf, vf, P + jnp.arange(T), jnp.arange(P + T), rel_bias, lam)
    y = diff_attn_out(o, sub_g, lam_init, w_out)
    return y, k.reshape(B, T, N_HEADS, 2 * HEAD_DIM), v


def setup_inputs(seed: int = 0) -> dict:
    key = jax.random.key(seed)
    ks = iter(jax.random.split(key, 48))
    nrm = lambda shape, s: jax.random.normal(next(ks), shape, jnp.float32) * s
    u_a = jax.random.uniform(next(ks), (N_A, D_RNN), jnp.float32, minval=0.9, maxval=0.999)
    a0 = u_a ** (1.0 / LRU_C)
    return {
        'x_prompt': nrm((BATCH, SEQ, D_MODEL), 1.0),
        'x_sample': nrm((DEC_BATCH, DEC_SEQ, D_MODEL), 1.0),
        'c_prompt': nrm((BATCH, D_MODEL), 1.0),
        'c_sample': nrm((DEC_BATCH, D_MODEL), 1.0),
        'state_lru_h': nrm((N_A, DEC_BATCH, D_RNN), 0.5),
        'state_lru_conv': nrm((N_A, DEC_BATCH, CONV_W - 1, D_RNN), 1.0),
        'state_pool': nrm((N_B, DEC_BATCH, POOL_HIST, D_MODEL), 1.0),
        'cache_k': nrm((N_C, DEC_BATCH, PAST_LEN, N_HEADS, 2 * HEAD_DIM), 1.0),
        'cache_v': nrm((N_C, DEC_BATCH, PAST_LEN, N_HEADS, 2 * HEAD_DIM), 1.0),
        'ada_w': nrm((DEPTH, D_MODEL, 9 * D_MODEL), D_MODEL ** -0.5),
        'ada_b': nrm((DEPTH, 9 * D_MODEL), 0.02),
        'norm_g': 1.0 + nrm((DEPTH, 3, D_MODEL), 0.02),
        'ffn_w_in': nrm((DEPTH, 2, D_MODEL, 2 * D_FF), D_MODEL ** -0.5),
        'ffn_w_out': nrm((DEPTH, 2, D_FF, D_MODEL), D_FF ** -0.5),
        'lru_w_in': nrm((N_A, D_MODEL, 2 * D_RNN), D_MODEL ** -0.5),
        'lru_conv_w': nrm((N_A, CONV_W, D_RNN), CONV_W ** -0.5),
        'lru_conv_b': nrm((N_A, D_RNN), 0.02),
        'lru_ga_w': nrm((N_A, LRU_BLOCKS, LRU_BS, LRU_BS), LRU_BS ** -0.5),
        'lru_ga_b': nrm((N_A, D_RNN), 0.02),
        'lru_gx_w': nrm((N_A, LRU_BLOCKS, LRU_BS, LRU_BS), LRU_BS ** -0.5),
        'lru_gx_b': nrm((N_A, D_RNN), 0.02),
        'lru_lambda': jnp.log(a0) - jnp.log1p(-a0),
        'lru_w_out': nrm((N_A, D_RNN, D_MODEL), D_RNN ** -0.5),
        'pool_w': nrm((N_B, POOL_GROUPS, POOL_GW, POOL_GW), POOL_GW ** -0.5),
        'pool_b': nrm((N_B, D_MODEL), 0.02),
        'pool_scale': 1.0 + nrm((N_B, D_MODEL), 0.02),
        'attn_w_in': nrm((N_C, D_MODEL, 3 * D_MODEL), D_MODEL ** -0.5),
        'attn_q_g': 1.0 + nrm((N_C, HEAD_DIM), 0.02),
        'attn_k_g': 1.0 + nrm((N_C, HEAD_DIM), 0.02),
        'attn_lambda': nrm((N_C, 4, HEAD_DIM), 0.1),
        'attn_sub_g': 1.0 + nrm((N_C, 2 * HEAD_DIM), 0.02),
        'attn_w_out': nrm((N_C, D_MODEL, D_MODEL), D_MODEL ** -0.5),
        'rel_bias': nrm((NUM_BUCKETS, N_HEADS), 0.5),
    }


def reference(x_prompt, x_sample, c_prompt, c_sample, state_lru_h, state_lru_conv, state_pool,
              cache_k, cache_v, ada_w, ada_b, norm_g, ffn_w_in, ffn_w_out, lru_w_in, lru_conv_w,
              lru_conv_b, lru_ga_w, lru_ga_b, lru_gx_w, lru_gx_b, lru_lambda, lru_w_out, pool_w,
              pool_b, pool_scale, attn_w_in, attn_q_g, attn_k_g, attn_lambda, attn_sub_g,
              attn_w_out, rel_bias):
    B, S, _ = x_prompt.shape
    T = x_sample.shape[1]
    xp, xs = x_prompt, x_sample
    h_p, h_s, cv_p, cv_s, pl_p, pl_s, k_p, v_p, k_s, v_s = [], [], [], [], [], [], [], [], [], []
    for l in range(DEPTH):
        kind = l % N_MIXERS
        j = l // N_MIXERS
        mp = adaln(c_prompt, ada_w[l], ada_b[l])
        ms = adaln(c_sample, ada_w[l], ada_b[l])
        xp = ffn_half(xp, mp[0], mp[1], mp[2], norm_g[l, 0], ffn_w_in[l, 0], ffn_w_out[l, 0])
        xs = ffn_half(xs, ms[0], ms[1], ms[2], norm_g[l, 0], ffn_w_in[l, 0], ffn_w_out[l, 0])
        up = modulate(xp, norm_g[l, 1], mp[3], mp[4])
        us = modulate(xs, norm_g[l, 1], ms[3], ms[4])
        if kind == 0:
            prm = (lru_w_in[j], lru_conv_w[j], lru_conv_b[j], lru_ga_w[j], lru_ga_b[j],
                   lru_gx_w[j], lru_gx_b[j], lru_lambda[j], lru_w_out[j])
            yp, bp, hp = rg_lru_mixer(up, jnp.zeros((B, CONV_W - 1, D_RNN), up.dtype),
                                      jnp.zeros((B, D_RNN), up.dtype), *prm)
            ys, bs, hs = rg_lru_mixer(us, state_lru_conv[j], state_lru_h[j], *prm)
            h_p.append(hp)
            h_s.append(hs)
            cv_p.append(bp)
            cv_s.append(bs)
        elif kind == 1:
            yp = pool_mixer(up, S, pool_w[j], pool_b[j], pool_scale[j])
            ext = jnp.concatenate([state_pool[j].astype(us.dtype), us], axis=1)
            ys = pool_mixer(ext, T, pool_w[j], pool_b[j], pool_scale[j])
            pl_p.append(up[:, -POOL_HIST:])
            pl_s.append(ext[:, -POOL_HIST:])
        else:
            lam_init = 0.8 - 0.6 * math.exp(-0.3 * l)
            lam = diff_lambda(attn_lambda[j], lam_init)
            prm = (attn_w_in[j], attn_q_g[j], attn_k_g[j], attn_sub_g[j], attn_w_out[j],
                   rel_bias, lam, lam_init)
            yp, kp, vp = diff_attn_prompt(up, *prm)
            ys, kn, vn = diff_attn_sample(us, cache_k[j], cache_v[j], *prm)
            k_p.append(kp)
            v_p.append(vp)
            k_s.append(kn)
            v_s.append(vn)
        xp = xp + mp[5][:, None, :] * yp
        xs = xs + ms[5][:, None, :] * ys
        xp = ffn_half(xp, mp[6], mp[7], mp[8], norm_g[l, 2], ffn_w_in[l, 1], ffn_w_out[l, 1])
        xs = ffn_half(xs, ms[6], ms[7], ms[8], norm_g[l, 2], ffn_w_in[l, 1], ffn_w_out[l, 1])
    return (xp, xs, jnp.stack(h_p), jnp.stack(h_s), jnp.stack(cv_p), jnp.stack(cv_s),
            jnp.stack(pl_p), jnp.stack(pl_s), jnp.stack(k_p), jnp.stack(v_p),
            jnp.stack(k_s), jnp.stack(v_s))
```

```cpp
#include <hip/hip_runtime.h>
#include <hip/hip_cooperative_groups.h>
#include <cstdio>
#include <cstdint>
namespace cg = cooperative_groups;

#define LAS __attribute__((address_space(3)))
typedef unsigned short bf16_t;
typedef short bf16x8 __attribute__((ext_vector_type(8)));
typedef short s16x4 __attribute__((ext_vector_type(4)));
typedef float f32x4 __attribute__((ext_vector_type(4)));
typedef float f32x16 __attribute__((ext_vector_type(16)));
typedef unsigned u32x4 __attribute__((ext_vector_type(4)));
typedef unsigned u32x2 __attribute__((ext_vector_type(2)));
#define DI __device__ __forceinline__
#define GAS __attribute__((address_space(1)))

constexpr int DM = 1024, NP = 16384, NS = 256, NT = NP + NS, SEQ = 8192, DSEQ = 32, NSEQ = 10;
constexpr int DFF = 2816, DRNN = 1280, PAST = 1024, TPS = 1088  , KVS = 1056;
constexpr int MODW = 9 * DM;
constexpr float EPS = 1e-6f;
constexpr float LOG2E = 1.4426950408889634f;
constexpr float QSC = 0.125f * LOG2E;
constexpr float LAM_INIT = 0.47071301834f;
constexpr size_t O_Y = 0, O_HP = 17039360, O_HS = 17044480, O_CP = 17064960, O_CS = 17080320, O_PP = 17141760, O_PS = 17172480,
                 O_KP = 17295360, O_VP = 34072576, O_KS = 50849792, O_VS = 51111936, O_END = 51374080;
constexpr size_t MiB = 1u << 20;
constexpr size_t WS_SPL = 512 * 1024  , WS_MODS = 1 * MiB, WS_WG = 3 * MiB, WS_AGG = 4 * MiB, WS_WI = 8 * MiB, WS_WO = 96 * MiB, WS_WLI = 140 * MiB, WS_WLO = 150 * MiB,
                 WS_WP = 155 * MiB, WS_WQKV = 156 * MiB, WS_WAO = 162 * MiB, WS_X = 164 * MiB, WS_U = 229 * MiB, WS_H = 262 * MiB,
                 WS_GB = 262 * MiB, WS_XB = 304 * MiB, WS_A = 352 * MiB, WS_BN = 434 * MiB,
                 WS_DP = 262 * MiB, WS_QB = 262 * MiB, WS_OB = 296 * MiB, WS_KB = 352 * MiB, WS_VT = 384 * MiB,
                 WS_KBS = 516 * MiB, WS_VTS = 533 * MiB, WS_END = 550 * MiB;
constexpr int LDS_BYTES = 147456;

DI unsigned cvt_pk_bf16(float lo, float hi) { unsigned r; asm volatile("v_cvt_pk_bf16_f32 %0, %1, %2" : "=v"(r) : "v"(lo), "v"(hi)); return r; }
DI float bf2f(unsigned short b) { return __uint_as_float(((unsigned)b) << 16); }
DI float bflo(unsigned w) { return __uint_as_float(w << 16); }
DI float bfhi(unsigned w) { return __uint_as_float(w & 0xffff0000u); }
DI int seq_of_row(int r) { return r < NP ? (r >> 13) : 2 + ((r - NP) >> 5); }
DI int pos_of_row(int r) { return r < NP ? (r & (SEQ - 1)) : ((r - NP) & (DSEQ - 1)); }
DI float wave_sum(float v) {
#pragma unroll
    for (int o = 1; o < 64; o <<= 1) v += __shfl_xor(v, o);
    return v;
}
DI float wave_max(float v) {
#pragma unroll
    for (int o = 1; o < 64; o <<= 1) v = fmaxf(v, __shfl_xor(v, o));
    return v;
}
DI float sigmoidf_(float x) { return __builtin_amdgcn_rcpf(1.f + __expf(-x)); }
DI float gelu_tanh(float x) { const float u = 0.7978845608028654f * (x + 0.044715f * x * x * x); const float t = 1.f - 2.f * __builtin_amdgcn_rcpf(1.f + __expf(2.f * u)); return 0.5f * x * (1.f + t); }

namespace pg8 {
constexpr int BM = 256, BK = 64, HALF = 128, HTB = HALF * BK * 2, STAGE_BYTES = 8 * HTB, NXCD = 8, WGM = 8;
DI int lds_byte(int r, int c) { const int st = (r >> 4) * 2 + (c >> 5), rr = r & 15, cc = c & 31, ob = rr * 64 + cc * 2; return st * 1024 + (ob ^ (((ob >> 9) & 1) << 5)); }
DI void stage_rc(int b, int& R, int& C) { const int st = b / 1024, sb = b % 1024, swz = sb ^ (((sb >> 9) & 1) << 5); R = (st >> 1) * 16 + swz / 64; C = (st & 1) * 32 + (swz % 64) / 2; }
DI int perm32(int rho) { const int n = rho >> 4, i = rho & 15; return 8 * (i >> 2) + 4 * n + (i & 3); }
struct Unit { int pm, pn; };
struct Gemm { const bf16_t* A; const bf16_t* Bt; int M, N, K, lda, ldb, a_pn_off; size_t kstepA, kstepB; };
struct StaticOrder {
    int nM, nN, nwg, G, c;
    DI void init(int M, int N, int G_, int c_) { nM = M / BM; nN = N / BM; nwg = nM * nN; G = G_; c = c_; }
    DI bool next(int i, Unit& u) const {
        const long L = (long)i * G + c; if (L >= nwg) return false;
        int wgid = (int)L; { const int q = nwg / NXCD, r = nwg % NXCD, xcd = wgid % NXCD, off = wgid / NXCD; wgid = (xcd < r ? xcd * (q + 1) : r * (q + 1) + (xcd - r) * q) + off; }
        const int nig = WGM * nN, gid = wgid / nig, fm = gid * WGM, gsz = (nM - fm) < WGM ? (nM - fm) : WGM;
        u.pm = fm + ((wgid % nig) % gsz); u.pn = (wgid % nig) / gsz; return true;
    }
};
template <class Epi>
DI void gemm_phase(LAS unsigned char* lds, const Gemm g, const StaticOrder& S, const Epi& E) {
    int tid_ = threadIdx.x; asm volatile("" : "+v"(tid_));
    const int tid = tid_, wid = __builtin_amdgcn_readfirstlane(tid >> 6), lane = tid & 63, wr = wid >> 2, wc = wid & 3, fr = lane & 15, fq = lane >> 4;
    const int K = g.K, nt = K / BK;
    unsigned voffA[2], voffB[2];
#pragma unroll
    for (int i = 0; i < 2; ++i) { int R, C; stage_rc(tid * 16 + i * 8192, R, C); const int Rb = (R & ~31) + perm32(R & 31);
        voffA[i] = (unsigned)(R * g.lda + C) * 2u; voffB[i] = (unsigned)(Rb * g.ldb + C) * 2u; }
    const size_t kstepA = g.kstepA, kstepB = g.kstepB;
    const size_t hstepA = (size_t)HALF * g.lda * 2, hstepB = (size_t)HALF * g.ldb * 2;
    const size_t tstepA = 2 * hstepA, tstepB = 2 * hstepB;
    const unsigned ldsw = (unsigned)wid * 1024u;
    const int aoff = lds_byte(wr * 64 + fr, fq * 8), boff = lds_byte(wc * 32 + fr, fq * 8);
#define PG8_SA(b, h) (((b) * 2 + (h)) * HTB)
#define PG8_SB(b, h) ((4 + (b) * 2 + (h)) * HTB)
#define PG8_STAGE(bufoff, gbase, voff) do { _Pragma("unroll") for (int _i = 0; _i < 2; ++_i) \
        __builtin_amdgcn_global_load_lds((const unsigned*)((const char*)(gbase) + (voff)[_i]), (LAS unsigned*)(lds + (bufoff) + ldsw + _i * 8192), 16, 0, 0); } while (0)
#define PG8_LDA(dst, b, h) do { _Pragma("unroll") for (int m = 0; m < 4; ++m) _Pragma("unroll") for (int k = 0; k < 2; ++k) dst[m][k] = *(const LAS bf16x8*)(lds + PG8_SA(b, h) + aoff + m * 2048 + k * 1024); } while (0)
#define PG8_LDB(dst, b, h) do { _Pragma("unroll") for (int n = 0; n < 2; ++n) _Pragma("unroll") for (int k = 0; k < 2; ++k) dst[n][k] = *(const LAS bf16x8*)(lds + PG8_SB(b, h) + boff + n * 2048 + k * 1024); } while (0)
#define PG8_MMA(ai, bj, At, Bt) do { __builtin_amdgcn_s_setprio(1); _Pragma("unroll") for (int m = 0; m < 4; ++m) _Pragma("unroll") for (int n = 0; n < 2; ++n) _Pragma("unroll") for (int k = 0; k < 2; ++k) \
        acc[ai][bj][m][n] = __builtin_amdgcn_mfma_f32_16x16x32_bf16(Bt[n][k], At[m][k], acc[ai][bj][m][n], 0, 0, 0); __builtin_amdgcn_s_setprio(0); } while (0)
#define PG8_WAIT_V(n) asm volatile("s_waitcnt vmcnt(" #n ")" ::: "memory")
#define PG8_WAIT_L(n) asm volatile("s_waitcnt lgkmcnt(" #n ")" ::: "memory")
#define PG8_BAR __builtin_amdgcn_s_barrier()
#define PG8_SCHED __builtin_amdgcn_sched_barrier(0)
    Unit cur, nxt; int ui = 0;
    if (!S.next(0, cur)) return;
    f32x4 acc[2][2][4][2];
#pragma unroll
    for (int a = 0; a < 2; ++a)
#pragma unroll
        for (int b = 0; b < 2; ++b)
#pragma unroll
            for (int m = 0; m < 4; ++m)
#pragma unroll
                for (int n = 0; n < 2; ++n) acc[a][b][m][n] = (f32x4){0.f, 0.f, 0.f, 0.f};
    bf16x8 At[4][2], B0[2][2], B1[2][2];
    const char* cA = (const char*)g.A + (size_t)cur.pm * tstepA + (size_t)cur.pn * g.a_pn_off * 2; const char* cB = (const char*)g.Bt + (size_t)cur.pn * tstepB;
    PG8_STAGE(PG8_SB(0, 0), cB, voffB); PG8_STAGE(PG8_SB(0, 1), cB + hstepB, voffB); PG8_STAGE(PG8_SA(0, 0), cA, voffA); PG8_STAGE(PG8_SA(0, 1), cA + hstepA, voffA);
    if (wr == 1) PG8_BAR;
    PG8_WAIT_V(2); PG8_BAR;
    PG8_STAGE(PG8_SB(1, 0), cB + kstepB, voffB); PG8_STAGE(PG8_SA(1, 0), cA + kstepA, voffA); PG8_STAGE(PG8_SB(1, 1), cB + hstepB + kstepB, voffB);
    PG8_WAIT_V(6); PG8_BAR;
    for (;;) {
        const bool has_next = S.next(ui + 1, nxt);
        const char* nA = has_next ? (const char*)g.A + (size_t)nxt.pm * tstepA + (size_t)nxt.pn * g.a_pn_off * 2 : cA; const char* nB = has_next ? (const char*)g.Bt + (size_t)nxt.pn * tstepB : cB;
        for (int t = 0; t < nt; t += 2) {
            const bool last = (t == nt - 2);
            const char* a1 = cA + (size_t)(t + 1) * kstepA;
            const char* a2 = last ? nA : cA + (size_t)(t + 2) * kstepA; const char* b2 = last ? nB : cB + (size_t)(t + 2) * kstepB;
            const char* a3 = a2 + kstepA; const char* b3 = b2 + kstepB;
            PG8_LDB(B0, 0, 0); PG8_LDB(B1, 0, 1); PG8_SCHED; PG8_LDA(At, 0, 0); PG8_STAGE(PG8_SA(1, 1), a1 + hstepA, voffA);
            PG8_WAIT_V(8); PG8_WAIT_L(0); PG8_BAR; PG8_MMA(0, 0, At, B0); PG8_MMA(0, 1, At, B1); PG8_BAR; PG8_SCHED;
            PG8_LDA(At, 0, 1); PG8_STAGE(PG8_SB(0, 0), b2, voffB); PG8_STAGE(PG8_SB(0, 1), b2 + hstepB, voffB); PG8_STAGE(PG8_SA(0, 0), a2, voffA);
            PG8_WAIT_V(8); PG8_WAIT_L(0); PG8_BAR; PG8_MMA(1, 0, At, B0); PG8_MMA(1, 1, At, B1); PG8_BAR; PG8_SCHED;
            PG8_LDB(B0, 1, 0); PG8_LDB(B1, 1, 1); PG8_SCHED; PG8_LDA(At, 1, 0); PG8_STAGE(PG8_SA(0, 1), a2 + hstepA, voffA);
            PG8_WAIT_V(8); PG8_WAIT_L(0); PG8_BAR; PG8_MMA(0, 0, At, B0); PG8_MMA(0, 1, At, B1); PG8_BAR; PG8_SCHED;
            PG8_LDA(At, 1, 1); PG8_STAGE(PG8_SB(1, 0), b3, voffB); PG8_STAGE(PG8_SB(1, 1), b3 + hstepB, voffB); PG8_STAGE(PG8_SA(1, 0), a3, voffA);
            PG8_WAIT_V(8); PG8_WAIT_L(0); PG8_BAR; PG8_MMA(1, 0, At, B0); PG8_MMA(1, 1, At, B1); PG8_BAR; PG8_SCHED;
        }
        if (wr == 0) PG8_BAR;
        E(acc, cur, wr, wc, fr, fq);
        if (!has_next) break;
#pragma unroll
        for (int a = 0; a < 2; ++a)
#pragma unroll
            for (int b = 0; b < 2; ++b)
#pragma unroll
                for (int m = 0; m < 4; ++m)
#pragma unroll
                    for (int n = 0; n < 2; ++n) acc[a][b][m][n] = (f32x4){0.f, 0.f, 0.f, 0.f};
        cur = nxt; cA = nA; cB = nB; ++ui;
        if (wr == 1) PG8_BAR;
    }
    PG8_WAIT_V(0);
    PG8_BAR;
#undef PG8_SA
#undef PG8_SB
#undef PG8_STAGE
#undef PG8_LDA
#undef PG8_LDB
#undef PG8_MMA
#undef PG8_WAIT_V
#undef PG8_WAIT_L
#undef PG8_BAR
#undef PG8_SCHED
}
}

struct Params { const float* in[33]; float* out; unsigned char* ws; };
constexpr int PTAB_OFF = 143360;
struct InTab { LAS unsigned char* lds;
    DI const float* operator[](int i) const { const unsigned long long v = *(volatile LAS unsigned long long*)(lds + PTAB_OFF + 8 * i);
        const unsigned lo = __builtin_amdgcn_readfirstlane((unsigned)v), hi = __builtin_amdgcn_readfirstlane((unsigned)(v >> 32)); return (const float*)(((unsigned long long)hi << 32) | lo); } };
struct Frame {
    LAS unsigned char* lds; int tid, lane, wave, G, gw, NGW, gtid, GT;
    InTab in; float* out; unsigned char* ws;
};
typedef pg8::Unit Unit;
typedef f32x4 Acc[2][2][4][2];

struct EpiSwiglu {
    bf16_t* H;
    DI void operator()(const Acc& acc, const Unit& u, int wr, int wc, int fr, int fq) const {
        asm volatile("" : "+v"(fr), "+v"(fq));
#pragma unroll
        for (int ai = 0; ai < 2; ++ai)
#pragma unroll
            for (int m = 0; m < 4; ++m) { const int row = u.pm * 256 + ai * 128 + wr * 64 + m * 16 + fr;
#pragma unroll
                for (int bj = 0; bj < 2; ++bj) { const int j0 = u.pn * 128 + bj * 64 + wc * 16 + 4 * fq; const f32x4 v0 = acc[ai][bj][m][0], v1 = acc[ai][bj][m][1];
                    const float h0 = v0[0] * sigmoidf_(v0[0]) * v0[1], h1 = v0[2] * sigmoidf_(v0[2]) * v0[3], h2 = v1[0] * sigmoidf_(v1[0]) * v1[1], h3 = v1[2] * sigmoidf_(v1[2]) * v1[3];
                    u32x2 w; w.x = cvt_pk_bf16(h0, h1); w.y = cvt_pk_bf16(h2, h3);
                    *(u32x2*)(H + (size_t)(j0 >> 6) * NT * 64 + (size_t)row * 64 + (j0 & 63)) = w; }
                asm volatile("" ::: "memory"); }
    }
};
template <bool XI32, bool XO32> struct EpiResidT {
    const void* xiP; const void* xiS; void* xo; const float* gate; float gsc; const float* pb; const float* ps;
    DI void operator()(const Acc& acc, const Unit& u, int wr, int wc, int fr, int fq) const {
        asm volatile("" : "+v"(fr), "+v"(fq));
#pragma unroll
        for (int ai = 0; ai < 2; ++ai)
#pragma unroll
            for (int m = 0; m < 4; ++m) { const int row = u.pm * 256 + ai * 128 + wr * 64 + m * 16 + fr; const int seq = seq_of_row(row);
                const float* gr = gate + (size_t)seq * MODW;
                const int colb = u.pn * 256 + wc * 32 + 8 * fq;
                f32x4 xv[2][2], gt[2][2];
#pragma unroll
                for (int bj = 0; bj < 2; ++bj) { const int c = colb + bj * 128;
                    if constexpr (XI32) { const float* xi = (const float*)xiP + (size_t)row * DM + c; xv[bj][0] = *(const f32x4*)xi; xv[bj][1] = *(const f32x4*)(xi + 4); }
                    else { const u32x4 q = *(const u32x4*)((const bf16_t*)xiP + (size_t)row * DM + c);
                        xv[bj][0] = (f32x4){bflo(q.x), bfhi(q.x), bflo(q.y), bfhi(q.y)}; xv[bj][1] = (f32x4){bflo(q.z), bfhi(q.z), bflo(q.w), bfhi(q.w)}; }
                    gt[bj][0] = *(const f32x4*)(gr + c); gt[bj][1] = *(const f32x4*)(gr + c + 4); }
#pragma unroll
                for (int bj = 0; bj < 2; ++bj) { const int c = colb + bj * 128; f32x4 o[2];
#pragma unroll
                    for (int n = 0; n < 2; ++n) { f32x4 v = acc[ai][bj][m][n];
                        if (pb) { v = (v + *(const f32x4*)(pb + c + 4 * n)) * *(const f32x4*)(ps + c + 4 * n); }
                        o[n] = xv[bj][n] + gsc * gt[bj][n] * v; }
                    if constexpr (XO32) { float* xr = (float*)xo + (size_t)row * DM + c; *(f32x4*)xr = o[0]; *(f32x4*)(xr + 4) = o[1]; }
                    else { u32x4 w; w.x = cvt_pk_bf16(o[0][0], o[0][1]); w.y = cvt_pk_bf16(o[0][2], o[0][3]); w.z = cvt_pk_bf16(o[1][0], o[1][1]); w.w = cvt_pk_bf16(o[1][2], o[1][3]);
                        *(u32x4*)((bf16_t*)xo + (size_t)row * DM + c) = w; } }
                asm volatile("" ::: "memory"); }
    }
};
struct EpiLruIn {
    bf16_t* GB; bf16_t* XB; float* convP; float* convS;
    DI void operator()(const Acc& acc, const Unit& u, int wr, int wc, int fr, int fq) const {
        asm volatile("" : "+v"(fr), "+v"(fq));
        const bool isx = u.pn >= 5;
#pragma unroll
        for (int ai = 0; ai < 2; ++ai)
#pragma unroll
            for (int m = 0; m < 4; ++m) { const int row = u.pm * 256 + ai * 128 + wr * 64 + m * 16 + fr;
#pragma unroll
                for (int bj = 0; bj < 2; ++bj) { const int col = u.pn * 256 + bj * 128 + wc * 32 + 8 * fq; f32x4 v0 = acc[ai][bj][m][0], v1 = acc[ai][bj][m][1];
                    if (!isx) {
#pragma unroll
                        for (int e = 0; e < 4; ++e) { v0[e] = gelu_tanh(v0[e]); v1[e] = gelu_tanh(v1[e]); }
                    }
                    u32x4 w; w.x = cvt_pk_bf16(v0[0], v0[1]); w.y = cvt_pk_bf16(v0[2], v0[3]); w.z = cvt_pk_bf16(v1[0], v1[1]); w.w = cvt_pk_bf16(v1[2], v1[3]);
                    if (!isx) *(u32x4*)(GB + (size_t)row * DRNN + col) = w;
                    else { const int c = col - DRNN; *(u32x4*)(XB + (size_t)row * DRNN + c) = w;
                        const int pos = pos_of_row(row), seq = seq_of_row(row); const int tl = row < NP ? SEQ : DSEQ;
                        if (pos >= tl - 3) { float* o = (row < NP ? convP + ((size_t)seq * 3 + (pos - (tl - 3))) * DRNN : convS + ((size_t)(seq - 2) * 3 + (pos - (tl - 3))) * DRNN) + c;
                            *(f32x4*)o = v0; *(f32x4*)(o + 4) = v1; } } }
                asm volatile("" ::: "memory"); }
    }
};
struct EpiQKV {
    bf16_t* Qb; bf16_t* Kb; bf16_t* Vt; bf16_t* Kbs; bf16_t* Vts; float* out; const float* qg; const float* kg;
    DI void operator()(const Acc& acc, const Unit& u, int wr, int wc, int fr, int fq) const {
        asm volatile("" : "+v"(fr), "+v"(fq));
        const int sg = 4 * u.pn + wc, typ = sg >> 4, s16 = sg & 15;
        const float* g = typ == 0 ? qg : kg;
        f32x4 gv[2][2];
        if (typ < 2) {
#pragma unroll
            for (int bj = 0; bj < 2; ++bj)
#pragma unroll
                for (int n = 0; n < 2; ++n) gv[bj][n] = *(const f32x4*)(g + 32 * bj + 8 * fq + 4 * n);
        }
#pragma unroll
        for (int ai = 0; ai < 2; ++ai)
#pragma unroll
            for (int m = 0; m < 4; ++m) { const int row = u.pm * 256 + ai * 128 + wr * 64 + m * 16 + fr;
                if (typ < 2) {
                    float ss = 0.f;
#pragma unroll
                    for (int bj = 0; bj < 2; ++bj)
#pragma unroll
                        for (int n = 0; n < 2; ++n) { const f32x4 x = acc[ai][bj][m][n]; ss += (x[0] * x[0] + x[1] * x[1]) + (x[2] * x[2] + x[3] * x[3]); }
                    ss += __shfl_xor(ss, 16); ss += __shfl_xor(ss, 32);
                    const float rstd = __builtin_amdgcn_rsqf(ss * (1.f / 64.f) + EPS);
#pragma unroll
                    for (int bj = 0; bj < 2; ++bj) { const int c = 64 * s16 + 32 * bj + 8 * fq;
                        f32x4 y0 = acc[ai][bj][m][0] * rstd * gv[bj][0], y1 = acc[ai][bj][m][1] * rstd * gv[bj][1];
                        if (typ == 0) { y0 = y0 * QSC; y1 = y1 * QSC;
                            u32x4 w; w.x = cvt_pk_bf16(y0[0], y0[1]); w.y = cvt_pk_bf16(y0[2], y0[3]); w.z = cvt_pk_bf16(y1[0], y1[1]); w.w = cvt_pk_bf16(y1[2], y1[3]);
                            *(u32x4*)(Qb + (size_t)row * DM + c) = w;
                        } else {
                            u32x4 w; w.x = cvt_pk_bf16(y0[0], y0[1]); w.y = cvt_pk_bf16(y0[2], y0[3]); w.z = cvt_pk_bf16(y1[0], y1[1]); w.w = cvt_pk_bf16(y1[2], y1[3]);
                            float* ko; bf16_t* kb;
                            if (row < NP) { ko = out + O_KP + (size_t)row * DM + c; kb = Kb + (size_t)row * DM + c; }
                            else { const int r2 = row - NP; ko = out + O_KS + (size_t)r2 * DM + c; kb = Kbs + ((size_t)(r2 >> 5) * TPS + PAST + (r2 & 31)) * DM + c; }
                            *(f32x4*)ko = y0; *(f32x4*)(ko + 4) = y1; *(u32x4*)kb = w; } }
                } else {
#pragma unroll
                    for (int bj = 0; bj < 2; ++bj) { const int c = 64 * s16 + 32 * bj + 8 * fq; const f32x4 y0 = acc[ai][bj][m][0], y1 = acc[ai][bj][m][1];
                        float* vo; bf16_t* vt; size_t tp;
                        if (row < NP) { vo = out + O_VP + (size_t)row * DM + c; tp = SEQ; vt = Vt + ((size_t)(row >> 13) * DM + c) * SEQ + (row & (SEQ - 1)); }
                        else { const int r2 = row - NP; vo = out + O_VS + (size_t)r2 * DM + c; tp = TPS; vt = Vts + ((size_t)(r2 >> 5) * DM + c) * TPS + PAST + (r2 & 31); }
                        *(f32x4*)vo = y0; *(f32x4*)(vo + 4) = y1;
                        const unsigned w0 = cvt_pk_bf16(y0[0], y0[1]), w1 = cvt_pk_bf16(y0[2], y0[3]), w2 = cvt_pk_bf16(y1[0], y1[1]), w3 = cvt_pk_bf16(y1[2], y1[3]);
                        vt[0] = (bf16_t)w0; vt[tp] = (bf16_t)(w0 >> 16); vt[2 * tp] = (bf16_t)w1; vt[3 * tp] = (bf16_t)(w1 >> 16);
                        vt[4 * tp] = (bf16_t)w2; vt[5 * tp] = (bf16_t)(w2 >> 16); vt[6 * tp] = (bf16_t)w3; vt[7 * tp] = (bf16_t)(w3 >> 16); } }
                asm volatile("" ::: "memory"); }
    }
};

template <bool SLAB, bool XI32, bool XO32>
DI void small_gemm_resid(const Frame& F, const bf16_t* A, int lda, int a_grp_off, const bf16_t* Bt, int K, const void* e_xiS, void* e_xo, const float* e_gate, float e_gsc, const float* e_pb, const float* e_ps) {
    const int fr = F.lane & 15, fq = F.lane >> 4;
    LAS float* red = (LAS float*)F.lds;
    const int ksl = K >> 3, nks = ksl >> 5;
#pragma unroll 1
    for (int t = blockIdx.x; t < 256; t += F.G) {
        const int rt = t >> 5, ct = t & 31; const int r0 = NP + 32 * rt, c0 = 32 * ct;
        const int kl = F.wave * ksl + 8 * fq;
        const bf16_t* ap = SLAB ? A + (size_t)(r0 + fr) * 64 : A + (size_t)(r0 + fr) * lda + (c0 >> 8) * a_grp_off + kl;
        const bf16_t* bp = SLAB ? Bt + (size_t)(c0 + fr) * 64 : Bt + (size_t)(c0 + fr) * K + kl;
        f32x4 acc[2][2];
#pragma unroll
        for (int j = 0; j < 2; ++j)
#pragma unroll
            for (int i = 0; i < 2; ++i) acc[j][i] = (f32x4){0.f, 0.f, 0.f, 0.f};
#pragma unroll 6
        for (int ks = 0; ks < nks; ++ks) {
            const int k = kl + 32 * ks;
            const size_t ao = SLAB ? (size_t)(k >> 6) * NT * 64 + (k & 63) : (size_t)(32 * ks), bo = SLAB ? (size_t)(k >> 6) * DM * 64 + (k & 63) : (size_t)(32 * ks);
            const size_t a16 = SLAB ? (size_t)16 * 64 : (size_t)16 * lda, b16 = SLAB ? (size_t)16 * 64 : (size_t)16 * K;
            const bf16x8 a0 = *(const bf16x8*)(ap + ao), a1 = *(const bf16x8*)(ap + ao + a16);
            const bf16x8 b0 = *(const bf16x8*)(bp + bo), b1 = *(const bf16x8*)(bp + bo + b16);
            acc[0][0] = __builtin_amdgcn_mfma_f32_16x16x32_bf16(b0, a0, acc[0][0], 0, 0, 0); acc[0][1] = __builtin_amdgcn_mfma_f32_16x16x32_bf16(b0, a1, acc[0][1], 0, 0, 0);
            acc[1][0] = __builtin_amdgcn_mfma_f32_16x16x32_bf16(b1, a0, acc[1][0], 0, 0, 0); acc[1][1] = __builtin_amdgcn_mfma_f32_16x16x32_bf16(b1, a1, acc[1][1], 0, 0, 0);
        }
#pragma unroll
        for (int j = 0; j < 2; ++j)
#pragma unroll
            for (int i = 0; i < 2; ++i)
#pragma unroll
                for (int e = 0; e < 4; ++e) red[(F.wave * 32 + 16 * i + fr) * 33 + 16 * j + 4 * fq + e] = acc[j][i][e];
        __syncthreads();
        { const int m = F.tid >> 4, n0 = (F.tid & 15) * 2; float v0 = 0.f, v1 = 0.f;
#pragma unroll
          for (int w = 0; w < 8; ++w) { v0 += red[(w * 32 + m) * 33 + n0]; v1 += red[(w * 32 + m) * 33 + n0 + 1]; }
          const int row = r0 + m, col = c0 + n0; const int seq = seq_of_row(row);
          if (e_pb) { v0 = (v0 + e_pb[col]) * e_ps[col]; v1 = (v1 + e_pb[col + 1]) * e_ps[col + 1]; }
          const float* gr = e_gate + (size_t)seq * MODW + col; float x0, x1;
          if constexpr (XI32) { const float* xi = (const float*)e_xiS + (size_t)row * DM + col; x0 = xi[0]; x1 = xi[1]; }
          else { const unsigned q = *(const unsigned*)((const bf16_t*)e_xiS + (size_t)row * DM + col); x0 = bflo(q); x1 = bfhi(q); }
          const float o0 = x0 + e_gsc * gr[0] * v0, o1 = x1 + e_gsc * gr[1] * v1;
          if constexpr (XO32) { float* xo = (float*)e_xo + (size_t)row * DM + col; xo[0] = o0; xo[1] = o1; }
          else *(unsigned*)((bf16_t*)e_xo + (size_t)row * DM + col) = cvt_pk_bf16(o0, o1); }
        __syncthreads();
    }
}

DI int dst_row(int mode, int n) {
    if (mode == 1) return n < DFF ? 2 * n : 2 * (n - DFF) + 1;
    if (mode == 2) { const int sg = n >> 6, e = n & 63; return ((sg >> 2) << 8) + ((e >> 5) << 7) + ((sg & 3) << 5) + (e & 31); }
    return n;
}
DI void transpose_item(const float* W, int K, int N, bf16_t* WT, int mode, LAS float* scr, int item, int lane) {
    const int nblk = N / 32, kb = item / nblk, nb = item % nblk, k0 = 64 * kb, n0 = 32 * nb;
    const float* wp_ = W + (size_t)(k0 + (lane >> 5)) * N + n0 + (lane & 31); const size_t wst = 2 * (size_t)N;
    { float wv[32];
#pragma unroll
        for (int i = 0; i < 32; ++i) { wv[i] = __builtin_nontemporal_load(wp_); wp_ += wst; }
#pragma unroll
        for (int i = 0; i < 32; ++i) scr[(2 * i + (lane >> 5)) * 33 + (lane & 31)] = wv[i]; }
    asm volatile("s_waitcnt lgkmcnt(0)" ::: "memory");
    const int c = lane & 7;
#pragma unroll
    for (int j = 0; j < 4; ++j) { const int n = (lane >> 3) + 8 * j; const LAS float* s = scr + (8 * c) * 33 + n;
        u32x4 o; o.x = cvt_pk_bf16(s[0 * 33], s[1 * 33]); o.y = cvt_pk_bf16(s[2 * 33], s[3 * 33]); o.z = cvt_pk_bf16(s[4 * 33], s[5 * 33]); o.w = cvt_pk_bf16(s[6 * 33], s[7 * 33]);
        if (mode == 3) *(u32x4*)(WT + (size_t)kb * N * 64 + (size_t)(n0 + n) * 64 + 8 * c) = o;
        else *(u32x4*)(WT + (size_t)dst_row(mode, n0 + n) * K + k0 + 8 * c) = o; }
    asm volatile("s_waitcnt lgkmcnt(0)" ::: "memory");
}
DI void adaln_layer(const Frame& F, int l, int b_idx, int b_cnt) {
    LAS float* sc = (LAS float*)F.lds; LAS float* part = sc + NSEQ * DM;
    const float* cp = F.in[2]; const float* cs = F.in[3]; const float* adab = F.in[10];
    for (int i = F.tid; i < NSEQ * DM; i += 512) { const int s = i >> 10, k = i & 1023; const float c = s < 2 ? cp[s * DM + k] : cs[(s - 2) * DM + k]; sc[i] = c / (1.f + __expf(-c)); }
    __syncthreads();
    float* MODS = (float*)(F.ws + WS_MODS);
#pragma unroll 1
    for (int task = b_idx; task < 144; task += b_cnt) {
        const int n0 = task * 64;
        const float* W = F.in[9] + (size_t)l * DM * MODW + n0 + F.lane;
        float acc[NSEQ];
#pragma unroll
        for (int s = 0; s < NSEQ; ++s) acc[s] = 0.f;
        const int k0 = F.wave * 128;
        const float* wp_ = W + (size_t)k0 * MODW;
#pragma unroll 1
        for (int kb = k0; kb < k0 + 128; kb += 16) {
            float wv[16];
#pragma unroll
            for (int i = 0; i < 16; ++i) { wv[i] = __builtin_nontemporal_load(wp_); wp_ += MODW; }
#pragma unroll
            for (int i = 0; i < 16; i += 4) {
#pragma unroll
                for (int s = 0; s < NSEQ; ++s) { const f32x4 c4 = *(const LAS f32x4*)(sc + s * DM + kb + i); acc[s] += (c4[0] * wv[i] + c4[1] * wv[i + 1]) + (c4[2] * wv[i + 2] + c4[3] * wv[i + 3]); } }
        }
#pragma unroll
        for (int s = 0; s < NSEQ; ++s) part[(F.wave * NSEQ + s) * 64 + F.lane] = acc[s];
        __syncthreads();
        for (int o = F.tid; o < NSEQ * 64; o += 512) { const int s = o >> 6, ln = o & 63; float sum = 0.f;
#pragma unroll
            for (int w = 0; w < 8; ++w) sum += part[(w * NSEQ + s) * 64 + ln];
            MODS[((size_t)l * NSEQ + s) * MODW + n0 + ln] = sum + adab[(size_t)l * MODW + n0 + ln]; }
        __syncthreads();
    }
    __syncthreads();
}
DI void convert_layer(const Frame& F, int l, int w_idx, int w_cnt) {
    LAS float* scr = (LAS float*)(F.lds + F.wave * 16384);
    int it = w_idx;
#define CONVW(Wp, K_, N_, WTp, mode, count) { const int per = ((K_) / 64) * ((N_) / 32); const int tot = per * (count); \
    for (; it < tot; it += w_cnt) { const int mi = it / per; transpose_item((Wp) + (size_t)mi * (K_) * (N_), (K_), (N_), (WTp) + (size_t)mi * (K_) * (N_), (mode), scr, it % per, F.lane); } it -= tot; }
    CONVW(F.in[12] + (size_t)(2 * l) * DM * 2 * DFF, DM, 2 * DFF, (bf16_t*)(F.ws + WS_WI) + (size_t)(2 * l) * DM * 2 * DFF, 1, 2)
    CONVW(F.in[13] + (size_t)(2 * l) * DFF * DM, DFF, DM, (bf16_t*)(F.ws + WS_WO) + (size_t)(2 * l) * DFF * DM, 3, 2)
    const int kind = l % 3, j = l / 3;
    if (kind == 0) {
        CONVW(F.in[14] + (size_t)j * DM * 2 * DRNN, DM, 2 * DRNN, (bf16_t*)(F.ws + WS_WLI) + (size_t)j * DM * 2 * DRNN, 0, 1)
        CONVW(F.in[22] + (size_t)j * DRNN * DM, DRNN, DM, (bf16_t*)(F.ws + WS_WLO) + (size_t)j * DRNN * DM, 0, 1)
    } else if (kind == 1) {
        CONVW(F.in[23], 256, 256, (bf16_t*)(F.ws + WS_WP), 0, 4)
    } else {
        CONVW(F.in[26], DM, 3 * DM, (bf16_t*)(F.ws + WS_WQKV), 2, 1)
        CONVW(F.in[31], DM, DM, (bf16_t*)(F.ws + WS_WAO), 0, 1)
    }
#undef CONVW
}
DI void phase_p0(const Frame& F) {
    adaln_layer(F, 0, blockIdx.x, F.G);
    convert_layer(F, 0, F.gw, F.NGW);
    { float* spl = (float*)(F.ws + WS_SPL); const float* lam = F.in[21];
      for (int i = F.gtid; i < 2 * DRNN; i += F.GT) spl[i] = log1pf(expf(-lam[i])); }
    {
        bf16_t* WG = (bf16_t*)(F.ws + WS_WG);
        for (int i = F.gtid; i < 2 * 16 * 160 * 96; i += F.GT) { const int k = i % 96, n = (i / 96) % 160, jh = i / (96 * 160);
            float v = 0.f; if (k < 80) v = n < 80 ? F.in[17][((size_t)jh * 80 + k) * 80 + n] : F.in[19][((size_t)jh * 80 + k) * 80 + n - 80];
            WG[i] = (bf16_t)(cvt_pk_bf16(v, 0.f) & 0xffffu); }
    }
    {
        bf16_t* Kbs = (bf16_t*)(F.ws + WS_KBS); bf16_t* Vts = (bf16_t*)(F.ws + WS_VTS);
        const float* ck = F.in[7]; const float* cv = F.in[8];
        for (int i = F.gtid; i < 8 * TPS * 128; i += F.GT) { const int c8 = i & 127, pos = (i >> 7) % TPS, s = i / (TPS * 128);
            if (pos >= PAST && pos < KVS) continue;
            u32x4 w = (u32x4){0u, 0u, 0u, 0u};
            if (pos < PAST) { const float* p = ck + ((size_t)s * PAST + pos) * DM + c8 * 8; const f32x4 a = *(const f32x4*)p, b = *(const f32x4*)(p + 4);
                w.x = cvt_pk_bf16(a[0], a[1]); w.y = cvt_pk_bf16(a[2], a[3]); w.z = cvt_pk_bf16(b[0], b[1]); w.w = cvt_pk_bf16(b[2], b[3]); }
            *(u32x4*)(Kbs + ((size_t)s * TPS + pos) * DM + c8 * 8) = w; }
        for (int i = F.gtid; i < 8 * (TPS / 8) * DM; i += F.GT) { const int hd = i & 1023, p8 = (i >> 10) % (TPS / 8), s = i / ((TPS / 8) * DM); const int pos = p8 * 8;
            if (pos >= PAST && pos < KVS) continue;
            u32x4 w = (u32x4){0u, 0u, 0u, 0u};
            if (pos < PAST) { const float* p = cv + ((size_t)s * PAST + pos) * DM + hd;
                w.x = cvt_pk_bf16(p[0], p[DM]); w.y = cvt_pk_bf16(p[2 * DM], p[3 * DM]); w.z = cvt_pk_bf16(p[4 * DM], p[5 * DM]); w.w = cvt_pk_bf16(p[6 * DM], p[7 * DM]); }
            *(u32x4*)(Vts + ((size_t)s * DM + hd) * TPS + pos) = w; }
    }
}

template <bool XI32>
DI void phase_mod(const Frame& F, const void* xP, const void* xS, const float* g, const float* mods_l, int sidx, bool pool_out) {
    bf16_t* U = (bf16_t*)(F.ws + WS_U);
    for (int row = F.gw; row < NT; row += F.NGW) {
        const int seq = seq_of_row(row);
        f32x4 v[4]; float ss = 0.f;
        if constexpr (XI32) { const float* xr = (const float*)(row < NP ? xP : xS) + (size_t)row * DM + 4 * F.lane;
#pragma unroll
            for (int j = 0; j < 4; ++j) v[j] = *(const f32x4*)(xr + 256 * j);
        } else { const bf16_t* xr = (const bf16_t*)xP + (size_t)row * DM + 4 * F.lane;
#pragma unroll
            for (int j = 0; j < 4; ++j) { const u32x2 q = *(const u32x2*)(xr + 256 * j); v[j] = (f32x4){bflo(q.x), bfhi(q.x), bflo(q.y), bfhi(q.y)}; } }
#pragma unroll
        for (int j = 0; j < 4; ++j) ss += (v[j][0] * v[j][0] + v[j][1] * v[j][1]) + (v[j][2] * v[j][2] + v[j][3] * v[j][3]);
        const float rstd = 1.f / sqrtf(wave_sum(ss) * (1.f / DM) + EPS);
        const float* sh = mods_l + (size_t)seq * MODW + sidx * DM; const float* sc = sh + DM;
        const int pos = pos_of_row(row); const int tl = row < NP ? SEQ : DSEQ;
        float* po = nullptr;
        if (pool_out && pos >= tl - 15) po = row < NP ? F.out + O_PP + ((size_t)seq * 15 + (pos - (tl - 15))) * DM : F.out + O_PS + ((size_t)(seq - 2) * 15 + (pos - (tl - 15))) * DM;
        f32x4 g4v[4], s4v[4], c4v[4];
#pragma unroll
        for (int j = 0; j < 4; ++j) { const int col = 4 * F.lane + 256 * j; g4v[j] = *(const f32x4*)(g + col); s4v[j] = *(const f32x4*)(sh + col); c4v[j] = *(const f32x4*)(sc + col); }
#pragma unroll
        for (int j = 0; j < 4; ++j) { const int col = 4 * F.lane + 256 * j;
            const f32x4 g4 = g4v[j], s4 = s4v[j], c4 = c4v[j];
            const f32x4 y = (v[j] * rstd) * g4 * (1.f + c4) + s4;
            u32x2 w; w.x = cvt_pk_bf16(y[0], y[1]); w.y = cvt_pk_bf16(y[2], y[3]);
            *(u32x2*)(U + (size_t)row * DM + col) = w;
            if (po) *(f32x4*)(po + col) = y; }
    }
}

template <int NV, bool FIRST>
DI void conv_vec(float (&x)[NV], const bf16_t* XB, const float* cw, const float* cb, const float* cbuf, int row, int pos, int c) {
#pragma unroll
    for (int e4 = 0; e4 < NV / 4; ++e4) { const f32x4 b4 = *(const f32x4*)(cb + c + 4 * e4);
#pragma unroll
        for (int e = 0; e < 4; ++e) x[4 * e4 + e] = b4[e]; }
#pragma unroll
    for (int k = 0; k < 4; ++k) { const int i = pos + k; float v[NV];
        if (!FIRST || i >= 3) { const bf16_t* src = XB + (size_t)(row - 3 + k) * DRNN + c;
            if (NV == 8) { const u32x4 q = *(const u32x4*)src; v[0] = bflo(q.x); v[1] = bfhi(q.x); v[2] = bflo(q.y); v[3] = bfhi(q.y); v[4 % NV] = bflo(q.z); v[5 % NV] = bfhi(q.z); v[6 % NV] = bflo(q.w); v[7 % NV] = bfhi(q.w); }
            else { const u32x2 q = *(const u32x2*)src; v[0] = bflo(q.x); v[1] = bfhi(q.x); v[2] = bflo(q.y); v[3] = bfhi(q.y); }
        } else if (cbuf) {
#pragma unroll
            for (int e4 = 0; e4 < NV / 4; ++e4) { const f32x4 a4 = *(const f32x4*)(cbuf + (size_t)i * DRNN + c + 4 * e4);
#pragma unroll
                for (int e = 0; e < 4; ++e) v[4 * e4 + e] = a4[e]; }
        } else {
#pragma unroll
            for (int e = 0; e < NV; ++e) v[e] = 0.f;
        }
#pragma unroll
        for (int e4 = 0; e4 < NV / 4; ++e4) { const f32x4 w4 = *(const f32x4*)(cw + k * DRNN + c + 4 * e4);
#pragma unroll
            for (int e = 0; e < 4; ++e) x[4 * e4 + e] += w4[e] * v[4 * e4 + e]; } }
}
struct LruP { const bf16_t* WG; const bf16_t* XB; float* A; float* Bn; const float* cw; const float* cb; const float* gab; const float* gxb; const float* spl; };
constexpr int XCP = 84;
template <bool FIRST>
DI void lru_tile2(const LruP& P, const float* cbuf, int hb, int row, int pos, int fr, int fq, LAS float* xcs) {
    bf16x8 W[2][6]; f32x4 C[2][3];
#define LRU_PRELOAD(buf, nt_) do { const bf16_t* wp0 = P.WG + ((size_t)(hb * 160 + 16 * (nt_) + fr)) * 96 + 8 * fq; const bf16_t* wp1 = wp0 + 80 * 96; \
        asm volatile("" : "+v"(wp0), "+v"(wp1)); \
        _Pragma("unroll") for (int ks = 0; ks < 3; ++ks) { W[buf][ks] = *(const bf16x8*)(wp0 + 32 * ks); W[buf][3 + ks] = *(const bf16x8*)(wp1 + 32 * ks); } \
        const int ch_ = 80 * hb + 16 * (nt_) + 4 * fq; C[buf][0] = *(const f32x4*)(P.gab + ch_); C[buf][1] = *(const f32x4*)(P.gxb + ch_); C[buf][2] = *(const f32x4*)(P.spl + ch_); } while (0)
    LRU_PRELOAD(0, 0);
    bf16x8 xf[2][3];
#pragma unroll
    for (int tl = 0; tl < 2; ++tl)
#pragma unroll
        for (int ks = 0; ks < 3; ++ks) { const int kc = 32 * ks + 8 * fq; u32x4 w = (u32x4){0u, 0u, 0u, 0u};
            if (kc < 80) { float x[8];
                if (tl == 0) conv_vec<8, FIRST>(x, P.XB, P.cw, P.cb, cbuf, row, pos, 80 * hb + kc); else conv_vec<8, false>(x, P.XB, P.cw, P.cb, nullptr, row + 16, pos + 16, 80 * hb + kc);
                w.x = cvt_pk_bf16(x[0], x[1]); w.y = cvt_pk_bf16(x[2], x[3]); w.z = cvt_pk_bf16(x[4], x[5]); w.w = cvt_pk_bf16(x[6], x[7]);
                LAS float* xp = xcs + (tl * 16 + fr) * XCP + kc;
                *(LAS f32x4*)xp = (f32x4){x[0], x[1], x[2], x[3]}; *(LAS f32x4*)(xp + 4) = (f32x4){x[4], x[5], x[6], x[7]}; }
            xf[tl][ks] = __builtin_bit_cast(bf16x8, w); }
    asm volatile("s_waitcnt lgkmcnt(0)" ::: "memory");
#pragma unroll
    for (int nt = 0; nt < 5; ++nt) {
        const int cur = nt & 1;
        if (nt < 4) LRU_PRELOAD(cur ^ 1, nt + 1);
        f32x4 ar[2], ai[2];
        ar[0] = (f32x4){0.f, 0.f, 0.f, 0.f}; ar[1] = ar[0]; ai[0] = ar[0]; ai[1] = ar[0];
#pragma unroll
        for (int ks = 0; ks < 3; ++ks)
#pragma unroll
            for (int tl = 0; tl < 2; ++tl) { ar[tl] = __builtin_amdgcn_mfma_f32_16x16x32_bf16(W[cur][ks], xf[tl][ks], ar[tl], 0, 0, 0); ai[tl] = __builtin_amdgcn_mfma_f32_16x16x32_bf16(W[cur][3 + ks], xf[tl][ks], ai[tl], 0, 0, 0); }
        const int ch = 80 * hb + 16 * nt + 4 * fq; f32x4 av[2], bv[2], xc[2];
#pragma unroll
        for (int tl = 0; tl < 2; ++tl) xc[tl] = *(const LAS f32x4*)(xcs + (tl * 16 + fr) * XCP + 16 * nt + 4 * fq);
        const f32x4 ga4 = C[cur][0], gx4 = C[cur][1], sp4 = C[cur][2];
#pragma unroll
        for (int tl = 0; tl < 2; ++tl)
#pragma unroll
            for (int e = 0; e < 4; ++e) {
                const float r = sigmoidf_(ar[tl][e] + ga4[e]), ig = sigmoidf_(ai[tl][e] + gx4[e]);
                const float la = -8.f * r * sp4[e]; const float a = __expf(la);
                av[tl][e] = (la > -0.03f) ? -la * (1.f + la * (0.5f + la * (0.16666667f + la * 0.041666668f))) : 1.f - a;
                const float t = 2.f * la; const float om = (t > -0.06f) ? -t * (1.f + t * (0.5f + t * (0.16666667f + t * 0.041666668f))) : 1.f - a * a;
                bv[tl][e] = __builtin_amdgcn_sqrtf(om) * (ig * xc[tl][e]); }
#pragma unroll
        for (int tl = 0; tl < 2; ++tl) { u32x4 w;
            w.x = cvt_pk_bf16(av[tl][0], bv[tl][0]); w.y = cvt_pk_bf16(av[tl][1], bv[tl][1]); w.z = cvt_pk_bf16(av[tl][2], bv[tl][2]); w.w = cvt_pk_bf16(av[tl][3], bv[tl][3]);
            *(u32x4*)((unsigned*)P.A + (size_t)(row + 16 * tl) * DRNN + ch) = w; } }
#undef LRU_PRELOAD
    asm volatile("s_waitcnt lgkmcnt(0)" ::: "memory");
}
DI void phase_lru_gates(const Frame& F, int j) {
    LruP P;
    P.WG = (const bf16_t*)(F.ws + WS_WG) + (size_t)j * 16 * 160 * 96; P.XB = (const bf16_t*)(F.ws + WS_XB);
    P.A = (float*)(F.ws + WS_A); P.Bn = (float*)(F.ws + WS_BN);
    P.cw = F.in[15] + (size_t)j * 4 * DRNN; P.cb = F.in[16] + (size_t)j * DRNN;
    P.gab = F.in[18] + (size_t)j * DRNN; P.gxb = F.in[20] + (size_t)j * DRNN; P.spl = (const float*)(F.ws + WS_SPL) + (size_t)j * DRNN;
    const float* cst = F.in[5];
    const int fr = F.lane & 15, fq = F.lane >> 4;
    LAS float* xcs = (LAS float*)(F.lds + F.wave * 16384);
#pragma unroll 1
    for (int task = F.gw; task < (NT / 32) * 16; task += F.NGW) {
        asm volatile("" ::: "memory");
        const int hb = task & 15, tp = task >> 4; const int row = tp * 32 + fr; const int seq = seq_of_row(row), pos = pos_of_row(row);
        const bool first = pos_of_row(tp * 32) == 0;
        if (first) { const float* cbuf = row < NP ? nullptr : cst + ((size_t)j * 8 + (seq - 2)) * 3 * DRNN; lru_tile2<true>(P, cbuf, hb, row, pos, fr, fq, xcs); }
        else lru_tile2<false>(P, nullptr, hb, row, pos, fr, fq, xcs);
    }
}
DI void chunk_info(int ch, int& row0, int& len) { if (ch < 256) { row0 = ch * 64; len = 64; } else { row0 = NP + (ch - 256) * 32; len = 32; } }
DI void phase_lru_agg(const Frame& F) {
    const float* A = (const float*)(F.ws + WS_A); const float* Bn = (const float*)(F.ws + WS_BN); float* AG = (float*)(F.ws + WS_AGG);
    for (int it = F.gtid; it < 264 * DRNN; it += F.GT) { const int ch = it / DRNN, c = it % DRNN; int row0, len; chunk_info(ch, row0, len);
        float P = 1.f, S = 0.f; const unsigned* ab = (const unsigned*)A + (size_t)row0 * DRNN + c;
#pragma unroll 16
        for (int t = 0; t < len; ++t) { const unsigned w = ab[(size_t)t * DRNN]; const float at = 1.f - bflo(w), bt = bfhi(w); S = at * S + bt; P *= at; }
        AG[it] = P; AG[264 * DRNN + it] = S; }
}
DI void phase_lru_apply(const Frame& F, int j) {
    const float* A = (const float*)(F.ws + WS_A); const float* Bn = (const float*)(F.ws + WS_BN); const float* AG = (const float*)(F.ws + WS_AGG);
    const bf16_t* GB = (const bf16_t*)(F.ws + WS_GB); bf16_t* HG = (bf16_t*)(F.ws + WS_XB);
    for (int it = F.gtid; it < 264 * DRNN; it += F.GT) { const int ch = it / DRNN, c = it % DRNN; int row0, len; chunk_info(ch, row0, len);
        float h; int f0; bool lastc; float* ho;
        if (ch < 256) { f0 = ch & ~127; h = 0.f; lastc = (ch & 127) == 127; ho = F.out + O_HP + ((size_t)j * 2 + (ch >> 7)) * DRNN + c; }
        else { f0 = ch; h = F.in[4][((size_t)j * 8 + (ch - 256)) * DRNN + c]; lastc = true; ho = F.out + O_HS + ((size_t)j * 8 + (ch - 256)) * DRNN + c; }
#pragma unroll 8
        for (int cc = f0; cc < ch; ++cc) h = AG[cc * DRNN + c] * h + AG[264 * DRNN + cc * DRNN + c];
        const unsigned* ab = (const unsigned*)A + (size_t)row0 * DRNN + c; const bf16_t* gp = GB + (size_t)row0 * DRNN + c; bf16_t* hp = HG + (size_t)row0 * DRNN + c;
        unsigned wv[2][16]; bf16_t gv[2][16];
#pragma unroll
        for (int i = 0; i < 16; ++i) { wv[0][i] = ab[(size_t)i * DRNN]; gv[0][i] = gp[(size_t)i * DRNN]; }
#pragma unroll
        for (int blk = 0; blk < 4; ++blk) { const int t0 = 16 * blk, cur = blk & 1;
            if (t0 < len) {
                if (t0 + 16 < len) {
#pragma unroll
                    for (int i = 0; i < 16; ++i) { wv[cur ^ 1][i] = ab[(size_t)(t0 + 16 + i) * DRNN]; gv[cur ^ 1][i] = gp[(size_t)(t0 + 16 + i) * DRNN]; } }
#pragma unroll
                for (int i = 0; i < 16; ++i) { h = (1.f - bflo(wv[cur][i])) * h + bfhi(wv[cur][i]); hp[(size_t)(t0 + i) * DRNN] = (bf16_t)(cvt_pk_bf16(bf2f(gv[cur][i]) * h, 0.f) & 0xffffu); } } }
        if (lastc) *ho = h; }
}

template <int W>
DI void pool_fast(const bf16_t* U, bf16_t* Dp, int row, int col0) {
    u32x4 q[W];
#pragma unroll
    for (int k = 0; k < W; ++k) q[k] = *(const u32x4*)(U + (size_t)(row - k) * DM + col0);
    float s[8];
#pragma unroll
    for (int e = 0; e < 8; ++e) s[e] = 0.f;
#pragma unroll
    for (int k = 0; k < W; ++k) { s[0] += bflo(q[k].x); s[1] += bfhi(q[k].x); s[2] += bflo(q[k].y); s[3] += bfhi(q[k].y); s[4] += bflo(q[k].z); s[5] += bfhi(q[k].z); s[6] += bflo(q[k].w); s[7] += bfhi(q[k].w); }
    const float ic = 1.f / (float)W;
    u32x4 o; o.x = cvt_pk_bf16(s[0] * ic - bflo(q[0].x), s[1] * ic - bfhi(q[0].x)); o.y = cvt_pk_bf16(s[2] * ic - bflo(q[0].y), s[3] * ic - bfhi(q[0].y));
    o.z = cvt_pk_bf16(s[4] * ic - bflo(q[0].z), s[5] * ic - bfhi(q[0].z)); o.w = cvt_pk_bf16(s[6] * ic - bflo(q[0].w), s[7] * ic - bfhi(q[0].w));
    *(u32x4*)(Dp + (size_t)row * DM + col0) = o;
}
DI void phase_pool(const Frame& F) {
    const bf16_t* U = (const bf16_t*)(F.ws + WS_U); bf16_t* Dp = (bf16_t*)(F.ws + WS_DP); const float* sp = F.in[6];
    for (int it = F.gtid; it < NT * 128; it += F.GT) {
        const int row = ((it >> 8) << 1) | ((it >> 5) & 1), grp = (it >> 6) & 3, col0 = grp * 256 + (it & 31) * 8; const int w = 2 << grp;
        const int seq = seq_of_row(row), pos = pos_of_row(row);
        if (pos >= 15) { if (grp == 0) pool_fast<2>(U, Dp, row, col0); else if (grp == 1) pool_fast<4>(U, Dp, row, col0); else if (grp == 2) pool_fast<8>(U, Dp, row, col0); else pool_fast<16>(U, Dp, row, col0); continue; }
        float s[8], u0[8];
#pragma unroll
        for (int e = 0; e < 8; ++e) { s[e] = 0.f; u0[e] = 0.f; }
        const int cnt = row < NP ? (pos + 1 < w ? pos + 1 : w) : w;
        for (int k = 0; k < cnt; ++k) { const int p = pos - k;
            if (p >= 0) { const u32x4 q = *(const u32x4*)(U + (size_t)(row - k) * DM + col0);
                const float x0 = bflo(q.x), x1 = bfhi(q.x), x2 = bflo(q.y), x3 = bfhi(q.y), x4 = bflo(q.z), x5 = bfhi(q.z), x6 = bflo(q.w), x7 = bfhi(q.w);
                if (k == 0) { u0[0] = x0; u0[1] = x1; u0[2] = x2; u0[3] = x3; u0[4] = x4; u0[5] = x5; u0[6] = x6; u0[7] = x7; }
                s[0] += x0; s[1] += x1; s[2] += x2; s[3] += x3; s[4] += x4; s[5] += x5; s[6] += x6; s[7] += x7;
            } else { const float* q = sp + ((size_t)(seq - 2) * 15 + (15 + p)) * DM + col0; const f32x4 a = *(const f32x4*)q, b = *(const f32x4*)(q + 4);
                s[0] += a[0]; s[1] += a[1]; s[2] += a[2]; s[3] += a[3]; s[4] += b[0]; s[5] += b[1]; s[6] += b[2]; s[7] += b[3]; } }
        const float ic = 1.f / (float)cnt;
        u32x4 o; o.x = cvt_pk_bf16(s[0] * ic - u0[0], s[1] * ic - u0[1]); o.y = cvt_pk_bf16(s[2] * ic - u0[2], s[3] * ic - u0[3]);
        o.z = cvt_pk_bf16(s[4] * ic - u0[4], s[5] * ic - u0[5]); o.w = cvt_pk_bf16(s[6] * ic - u0[6], s[7] * ic - u0[7]);
        *(u32x4*)(Dp + (size_t)row * DM + col0) = o; }
}

constexpr int KPITCH = 144, VPITCH = 136, KBUF = 64 * KPITCH, VBUF = 128 * VPITCH;
constexpr int L_K = 0, L_V = 3 * KBUF, L_TAB = L_V + 3 * VBUF;
static_assert(L_TAB + 320 * 4 <= PTAB_OFF, "attention LDS");
DI int t5_bucket(int rel) {
    int ret = rel > 0 ? 16 : 0; const int n = rel < 0 ? -rel : rel;
    if (n < 8) return ret + n;
    int large = 8 + (int)(logf((float)n / 8.f) / 2.772588722239781f * 8.f); if (large > 15) large = 15;
    return ret + large;
}
struct AttnUnit { const bf16_t* Kb; const bf16_t* Vt; int tpad, kvlen, h, qrow0, qpos0, nq, ntiles; };
#define ATT_BAR() do { asm volatile("s_waitcnt lgkmcnt(0)" ::: "memory"); __builtin_amdgcn_s_barrier(); asm volatile("" ::: "memory"); } while (0)
DI void attn_unit(const Frame& F, const AttnUnit& u, float lam, float bound, float* park) {
    const int tid = F.tid, lane = F.lane, wave = F.wave, q = lane & 31, hi = lane >> 5;
    const bf16_t* Qb = (const bf16_t*)(F.ws + WS_QB); bf16_t* Ob = (bf16_t*)(F.ws + WS_OB);
    const float* relb = F.in[32];
    LAS unsigned char* lds = F.lds;
    LAS float* tab = (LAS float*)(lds + L_TAB);
    for (int i = tid; i < 319; i += 512) tab[i] = (relb[t5_bucket(i - 255) * 8 + u.h] - bound) * LOG2E;
    const float cfar = (relb[15 * 8 + u.h] - bound) * LOG2E;
    const bool active = 32 * wave < u.nq;
    const bool qvalid = active && (q < u.nq - 32 * wave);
    const int qposw = u.qpos0 + 32 * wave; const int qc = qposw >> 6;
    const int myq = qposw + q;
    const int klds = (tid >> 3) * KPITCH + (tid & 7) * 16, vlds = (tid >> 3) * VPITCH + (tid & 7) * 16;
    const GAS bf16_t* vg0 = (const GAS bf16_t*)(u.Vt + ((size_t)(u.h * 128 + (tid >> 3))) * u.tpad + (tid & 7) * 8);
    const size_t vrow64 = (size_t)64 * u.tpad;
    GAS float* pk = (GAS float*)(park + (size_t)tid * 64);
    const int nt = u.ntiles;
#pragma unroll 1
    for (int c = 0; c < 2; ++c) {
        const GAS bf16_t* kg0 = (const GAS bf16_t*)(u.Kb + (size_t)(tid >> 3) * DM + u.h * 128 + c * 64 + (tid & 7) * 8);
        bf16x8 qf[4];
        { const GAS bf16_t* qp = (const GAS bf16_t*)(Qb + (size_t)(u.qrow0 + 32 * wave + q) * DM + u.h * 128 + c * 64 + hi * 8);
#pragma unroll
          for (int ks = 0; ks < 4; ++ks) { u32x4 w = (u32x4){0u, 0u, 0u, 0u}; if (qvalid) w = *(const GAS u32x4*)(qp + ks * 16); qf[ks] = __builtin_bit_cast(bf16x8, w); } }
        u32x4 kA, vA0, vA1, kB, vB0, vB1;
#define ATT_LOAD(K_, V0_, V1_, kt) do { K_ = *(const GAS u32x4*)(kg0 + (size_t)(kt) * 64 * DM); V0_ = *(const GAS u32x4*)(vg0 + (kt) * 64); V1_ = *(const GAS u32x4*)(vg0 + vrow64 + (kt) * 64); } while (0)
#define ATT_WRITE(K_, V0_, V1_, b) do { *(LAS u32x4*)(lds + L_K + (b) * KBUF + klds) = K_; \
        *(LAS u32x2*)(lds + L_V + (b) * VBUF + vlds) = (u32x2){V0_.x, V0_.y}; *(LAS u32x2*)(lds + L_V + (b) * VBUF + vlds + 8) = (u32x2){V0_.z, V0_.w}; \
        *(LAS u32x2*)(lds + L_V + (b) * VBUF + vlds + 64 * VPITCH) = (u32x2){V1_.x, V1_.y}; *(LAS u32x2*)(lds + L_V + (b) * VBUF + vlds + 64 * VPITCH + 8) = (u32x2){V1_.z, V1_.w}; } while (0)
        f32x16 O[4];
#pragma unroll
        for (int d = 0; d < 4; ++d)
#pragma unroll
            for (int e = 0; e < 16; ++e) O[d][e] = 0.f;
        float lsum = 0.f;
#define ATT_VLD(dst, db, k2, b) do { const int vo = L_V + (b) * VBUF + (32 * (db) + q) * VPITCH + (16 * (k2) + 4 * hi) * 2; \
            const u32x2 lo = *(const LAS u32x2*)(lds + vo), hi2 = *(const LAS u32x2*)(lds + vo + 16); dst = __builtin_bit_cast(bf16x8, ((u32x4){lo.x, lo.y, hi2.x, hi2.y})); } while (0)
#define ATT_COMPUTE(kt, b) do { if (active && (kt) <= qc) { \
            const bool nearb = ((kt) >= qc - 2) || (64 * (kt) + 64 > u.kvlen); \
            bf16x8 P[4]; f32x16 S[2]; \
            { bf16x8 kf[2][4]; \
              _Pragma("unroll") for (int mb = 0; mb < 2; ++mb) _Pragma("unroll") for (int ks = 0; ks < 4; ++ks) \
                  kf[mb][ks] = *(const LAS bf16x8*)(lds + L_K + (b) * KBUF + (32 * mb + q) * KPITCH + ks * 32 + hi * 16); \
              const float sinit = nearb ? 0.f : cfar; \
              _Pragma("unroll") for (int mb = 0; mb < 2; ++mb) _Pragma("unroll") for (int e = 0; e < 16; ++e) S[mb][e] = sinit; \
              _Pragma("unroll") for (int ks = 0; ks < 4; ++ks) _Pragma("unroll") for (int mb = 0; mb < 2; ++mb) \
                  S[mb] = __builtin_amdgcn_mfma_f32_32x32x16_bf16(kf[mb][ks], qf[ks], S[mb], 0, 0, 0); } \
            bf16x8 v0[4], v1[4]; \
            _Pragma("unroll") for (int i = 0; i < 4; ++i) ATT_VLD(v0[i], 0, i, b); \
            __builtin_amdgcn_sched_barrier(0); \
            _Pragma("unroll") for (int mb = 0; mb < 2; ++mb) { \
                if (!nearb) { \
                    _Pragma("unroll") for (int e = 0; e < 16; ++e) { const float p = __builtin_amdgcn_exp2f(S[mb][e]); S[mb][e] = p; lsum += p; } \
                } else { \
                    const int kb_ = 64 * (kt) + 4 * hi; const LAS float* tb_ = tab + (kb_ - myq + 255);     \
                    _Pragma("unroll") for (int e = 0; e < 16; ++e) { const int ce = 32 * mb + (e & 3) + 8 * (e >> 2); \
                        float p = __builtin_amdgcn_exp2f(S[mb][e] + tb_[ce]); if (kb_ + ce >= u.kvlen) p = 0.f; S[mb][e] = p; lsum += p; } \
                } \
                _Pragma("unroll") for (int k1 = 0; k1 < 2; ++k1) { const int e0 = 8 * k1; u32x4 w; \
                    w.x = cvt_pk_bf16(S[mb][e0 + 0], S[mb][e0 + 1]); w.y = cvt_pk_bf16(S[mb][e0 + 2], S[mb][e0 + 3]); w.z = cvt_pk_bf16(S[mb][e0 + 4], S[mb][e0 + 5]); w.w = cvt_pk_bf16(S[mb][e0 + 6], S[mb][e0 + 7]); \
                    P[2 * mb + k1] = __builtin_bit_cast(bf16x8, w); } \
            } \
            __builtin_amdgcn_sched_barrier(0); \
            _Pragma("unroll") for (int i = 0; i < 4; ++i) ATT_VLD(v1[i], 1, i, b); \
            _Pragma("unroll") for (int i = 0; i < 4; ++i) O[0] = __builtin_amdgcn_mfma_f32_32x32x16_bf16(v0[i], P[i], O[0], 0, 0, 0); \
            __builtin_amdgcn_sched_barrier(0); \
            _Pragma("unroll") for (int i = 0; i < 4; ++i) ATT_VLD(v0[i], 2, i, b); \
            _Pragma("unroll") for (int i = 0; i < 4; ++i) O[1] = __builtin_amdgcn_mfma_f32_32x32x16_bf16(v1[i], P[i], O[1], 0, 0, 0); \
            __builtin_amdgcn_sched_barrier(0); \
            _Pragma("unroll") for (int i = 0; i < 4; ++i) ATT_VLD(v1[i], 3, i, b); \
            _Pragma("unroll") for (int i = 0; i < 4; ++i) O[2] = __builtin_amdgcn_mfma_f32_32x32x16_bf16(v0[i], P[i], O[2], 0, 0, 0); \
            __builtin_amdgcn_sched_barrier(0); \
            _Pragma("unroll") for (int i = 0; i < 4; ++i) O[3] = __builtin_amdgcn_mfma_f32_32x32x16_bf16(v1[i], P[i], O[3], 0, 0, 0); \
        } } while (0)
        ATT_LOAD(kA, vA0, vA1, 0);
        if (nt > 1) ATT_LOAD(kB, vB0, vB1, 1);
        ATT_WRITE(kA, vA0, vA1, 0);
        ATT_BAR();
        int b0 = 0;
#pragma unroll 1
        for (int kt = 0; kt < nt; kt += 2) {
            const int b1 = b0 == 2 ? 0 : b0 + 1, b2 = b1 == 2 ? 0 : b1 + 1;
            if (kt + 2 < nt) ATT_LOAD(kA, vA0, vA1, kt + 2);
            ATT_COMPUTE(kt, b0);
            if (kt + 1 < nt) ATT_WRITE(kB, vB0, vB1, b1);
            ATT_BAR();
            if (kt + 1 >= nt) break;
            if (kt + 3 < nt) ATT_LOAD(kB, vB0, vB1, kt + 3);
            ATT_COMPUTE(kt + 1, b1);
            if (kt + 2 < nt) ATT_WRITE(kA, vA0, vA1, b2);
            ATT_BAR();
            b0 = b2;
        }
#undef ATT_LOAD
#undef ATT_WRITE
#undef ATT_COMPUTE
#undef ATT_VLD
        if (active) {
            const float lt = lsum + __shfl_xor(lsum, 32);
            if (c == 0) { const float i1 = 1.f / lt;
#pragma unroll
                for (int db = 0; db < 4; ++db)
#pragma unroll
                    for (int e4 = 0; e4 < 4; ++e4) *(GAS f32x4*)(pk + db * 16 + e4 * 4) = (f32x4){O[db][4 * e4] * i1, O[db][4 * e4 + 1] * i1, O[db][4 * e4 + 2] * i1, O[db][4 * e4 + 3] * i1};
            } else {
                const float i2 = lam / lt; float ss = 0.f;
#pragma unroll
                for (int db = 0; db < 4; ++db)
#pragma unroll
                    for (int e4 = 0; e4 < 4; ++e4) { const f32x4 pv = *(const GAS f32x4*)(pk + db * 16 + e4 * 4);
#pragma unroll
                        for (int e = 0; e < 4; ++e) { const float o = pv[e] - O[db][4 * e4 + e] * i2; O[db][4 * e4 + e] = o; ss += o * o; } }
                ss += __shfl_xor(ss, 32);
                const float rstd = (1.f - LAM_INIT) / sqrtf(ss * (1.f / 128.f) + EPS);
                const float* sg = F.in[30];
                if (qvalid) {
                    GAS bf16_t* orow = (GAS bf16_t*)(Ob + (size_t)(u.qrow0 + 32 * wave + q) * DM + u.h * 128);
#pragma unroll
                    for (int db = 0; db < 4; ++db)
#pragma unroll
                        for (int e4 = 0; e4 < 4; ++e4) { const int d = 32 * db + 8 * e4 + 4 * hi; const f32x4 g4 = *(const GAS f32x4*)((const GAS float*)sg + d);
                            u32x2 w; w.x = cvt_pk_bf16(O[db][4 * e4] * rstd * g4[0], O[db][4 * e4 + 1] * rstd * g4[1]); w.y = cvt_pk_bf16(O[db][4 * e4 + 2] * rstd * g4[2], O[db][4 * e4 + 3] * rstd * g4[3]);
                            *(GAS u32x2*)(orow + d) = w; }
                }
            }
        }
    }
}
DI void phase_attn(const Frame& F) {
    const float* lp = F.in[29];
    const float s1 = wave_sum(lp[F.lane] * lp[64 + F.lane]), s2 = wave_sum(lp[128 + F.lane] * lp[192 + F.lane]);
    const float lam = __expf(s1) - __expf(s2) + LAM_INIT;
    const float mq = wave_max(fabsf(F.in[27][F.lane])), mk = wave_max(fabsf(F.in[28][F.lane]));
    float mb = 0.f;
#pragma unroll
    for (int i = 0; i < 4; ++i) mb = fmaxf(mb, fabsf(F.in[32][F.lane + 64 * i]));
    mb = wave_max(mb);
    const float bound = 8.f * mq * mk * 1.02f + mb + 0.25f;
    const bf16_t* Kb = (const bf16_t*)(F.ws + WS_KB); const bf16_t* Vt = (const bf16_t*)(F.ws + WS_VT);
    const bf16_t* Kbs = (const bf16_t*)(F.ws + WS_KBS); const bf16_t* Vts = (const bf16_t*)(F.ws + WS_VTS);
    float* park = (float*)(F.ws + WS_BN) + (size_t)blockIdx.x * 64 * 512;
#pragma unroll 1
    for (int p = blockIdx.x; p < 256; p += F.G) {
        const int bh = p >> 4, qa = p & 15, b = bh >> 3, h = bh & 7;
#pragma unroll 1
        for (int half = 0; half < 2; ++half) { const int qb = half == 0 ? 31 - qa : qa;
            AttnUnit u; u.Kb = Kb + (size_t)b * SEQ * DM; u.Vt = Vt + (size_t)b * DM * SEQ; u.tpad = SEQ; u.kvlen = SEQ; u.h = h; u.qrow0 = b * SEQ + qb * 256; u.qpos0 = qb * 256; u.nq = 256; u.ntiles = 4 * (qb + 1);
            attn_unit(F, u, lam, bound, park); }
    }
#pragma unroll 1
    for (int p = blockIdx.x; p < 64; p += F.G) {
        const int s = p >> 3, h = p & 7;
        AttnUnit u; u.Kb = Kbs + (size_t)s * TPS * DM; u.Vt = Vts + (size_t)s * DM * TPS; u.tpad = TPS; u.kvlen = KVS; u.h = h; u.qrow0 = NP + 32 * s; u.qpos0 = PAST; u.nq = 32; u.ntiles = 17;
        attn_unit(F, u, lam, bound, park);
    }
}

#define XB_TMO      128
#define XB_XCNT(j)  (256  + 64 * (j))
#define XB_XSUB(j)  (1280 + 64 * (j))
#define XB_XGEN(j)  (2304 + 64 * (j))
#define XB_TOP      3328
#define XB_TOPGEN   3392
#define XB_SPIN_CAP (1u << 22)
DI unsigned xb_ld(unsigned* p)              { return __hip_atomic_load(p, __ATOMIC_RELAXED, __HIP_MEMORY_SCOPE_AGENT); }
DI unsigned xb_add(unsigned* p, unsigned v) { return __hip_atomic_fetch_add(p, v, __ATOMIC_RELAXED, __HIP_MEMORY_SCOPE_AGENT); }
DI unsigned xb_xcc_id() { return (unsigned)__builtin_amdgcn_s_getreg((3 << 11) | 20) & 0xFu; }
#define XB_SPIN(cond, bar) do { unsigned _sp = 0; while (cond) { __builtin_amdgcn_s_sleep(1); \
    if ((++_sp & 255u) == 0u) { if (xb_ld(&(bar)[XB_TMO])) break; if (_sp > XB_SPIN_CAP) { atomicAdd(&(bar)[XB_TMO], 1u); break; } } } } while (0)
struct XcdBarrier { unsigned* bar; unsigned x; volatile LAS unsigned* st; };
DI XcdBarrier xcd_barrier_post(unsigned* bar, volatile LAS unsigned* st) {
    XcdBarrier b; b.bar = bar; b.x = xb_xcc_id(); b.st = st;
    if (threadIdx.x == 0) (void)xb_add(&bar[XB_XCNT(b.x)], 1u);
    return b;
}
DI void xcd_barrier_complete(unsigned* bar, unsigned x, unsigned& nloc, unsigned& nx) {
    const unsigned G = gridDim.x * gridDim.y * gridDim.z;
    unsigned sum, cnt, mine, sp = 0u;
    for (;;) {
        sum = 0u; cnt = 0u; mine = 0u;
#pragma unroll
        for (unsigned j = 0; j < 16; ++j) { const unsigned c = xb_ld(&bar[XB_XCNT(j)]); sum += c; cnt += (c > 0u) ? 1u : 0u; mine = (j == x) ? c : mine; }
        if (sum == G) break;
        __builtin_amdgcn_s_sleep(1);
        if ((++sp & 255u) == 0u) { if (xb_ld(&bar[XB_TMO])) break; if (sp > XB_SPIN_CAP) { atomicAdd(&bar[XB_TMO], 1u); break; } }
    }
    nloc = mine > 0u ? mine : 1u; nx = cnt > 0u ? cnt : 1u;
}
DI void xcd_barrier(const XcdBarrier& b) {
    asm volatile("s_waitcnt vmcnt(0)" ::: "memory");
    __syncthreads();
    if (threadIdx.x == 0) {
        unsigned* bar = b.bar;
        __builtin_amdgcn_s_waitcnt(0);
        unsigned nloc = b.st[0], nx = b.st[1];
        if (nloc == 0u) { xcd_barrier_complete(bar, b.x, nloc, nx); b.st[0] = nloc; b.st[1] = nx; }
        const unsigned old = xb_add(&bar[XB_XSUB(b.x)], 1u);
        const unsigned gen = old / nloc;
        if (old + 1u == (gen + 1u) * nloc) {
            __builtin_amdgcn_fence(__ATOMIC_RELEASE, "agent");
            asm volatile("s_waitcnt vmcnt(0)" ::: "memory");
            const unsigned og = xb_add(&bar[XB_TOP], 1u);
            const unsigned tg = og / nx;
            if (og + 1u == (tg + 1u) * nx) xb_add(&bar[XB_TOPGEN], 1u);
            else XB_SPIN(xb_ld(&bar[XB_TOPGEN]) == tg, bar);
            __builtin_amdgcn_fence(__ATOMIC_ACQUIRE, "agent");
            xb_add(&bar[XB_XGEN(b.x)], 1u);
            asm volatile("s_waitcnt vmcnt(0)" ::: "memory");
        } else {
            XB_SPIN(xb_ld(&bar[XB_XGEN(b.x)]) == gen, bar);
            __builtin_amdgcn_fence(__ATOMIC_ACQUIRE, "agent");
            asm volatile("s_waitcnt vmcnt(0)" ::: "memory");
        }
    }
    __syncthreads();
}

__global__ void __launch_bounds__(512) fwd_megakernel(Params p) {
    extern __shared__ __attribute__((aligned(16))) unsigned char lds_raw[];
    cg::grid_group grid = cg::this_grid();
    Frame F;
    F.lds = (LAS unsigned char*)lds_raw; F.tid = threadIdx.x; F.lane = F.tid & 63; F.wave = __builtin_amdgcn_readfirstlane(F.tid >> 6);
    F.G = gridDim.x; F.gw = blockIdx.x * 8 + F.wave; F.NGW = F.G * 8; F.gtid = blockIdx.x * 512 + F.tid; F.GT = F.G * 512;
    F.in.lds = F.lds;
    volatile LAS unsigned* xst = (volatile LAS unsigned*)(F.lds + PTAB_OFF + 512);
    if (F.tid == 0) { xst[0] = 0u; xst[1] = 0u; }
    if (F.tid == 0) { LAS unsigned long long* pt = (LAS unsigned long long*)(F.lds + PTAB_OFF);
#pragma unroll
        for (int i = 0; i < 33; ++i) pt[i] = (unsigned long long)p.in[i];
        pt[33] = (unsigned long long)p.out; pt[34] = (unsigned long long)p.ws; }
    __syncthreads();
#define PH() do { asm volatile("" ::: "memory"); int t_ = threadIdx.x; asm volatile("" : "+v"(t_)); F.tid = t_; F.lane = t_ & 63; F.wave = __builtin_amdgcn_readfirstlane(t_ >> 6); \
        F.gw = blockIdx.x * 8 + F.wave; F.gtid = blockIdx.x * 512 + t_; F.out = (float*)F.in[33]; F.ws = (unsigned char*)F.in[34]; } while (0)
#define WSP(off) (F.ws + (off))
#define X_ ((bf16_t*)WSP(WS_X))
#define U_ ((const bf16_t*)WSP(WS_U))
#define H_ ((bf16_t*)WSP(WS_H))
#define MODSL ((const float*)WSP(WS_MODS) + (size_t)l * NSEQ * MODW)
#define NG (F.in[11] + (size_t)l * 3 * DM)
#ifdef PROBE_SYNC
#define SYNC() do { xcd_barrier(xbar); xcd_barrier(xbar); PH(); } while (0)
#else
#define SYNC() do { xcd_barrier(xbar); PH(); } while (0)
#endif
#ifdef PROBE_MOD
#define PMOD(T, ...) do { phase_mod<T>(__VA_ARGS__); phase_mod<T>(__VA_ARGS__); } while (0)
#else
#define PMOD(T, ...) phase_mod<T>(__VA_ARGS__)
#endif
    pg8::StaticOrder S;
#define RESID(XI, XO, SLAB_, xiP_, xiS_, xo_, gsc_, pb_, ps_) do { const void* r_xiP = (xiP_); const void* r_xiS = (xiS_); void* r_xo = (xo_); const float* r_pb = (pb_); const float* r_ps = (ps_); \
        { EpiResidT<XI, XO> E{r_xiP, r_xiS, r_xo, r_gate, gsc_, r_pb, r_ps}; pg8::gemm_phase(F.lds, g, S, E); } \
        small_gemm_resid<SLAB_, XI, XO>(F, g.A, g.lda, g.a_pn_off, g.Bt, g.K, r_xiS, r_xo, r_gate, gsc_, r_pb, r_ps); } while (0)
    PH();
    XcdBarrier xbar = xcd_barrier_post((unsigned*)F.ws, xst);
#ifndef NO_P0
    phase_p0(F);
#ifdef PROBE_P0
    __syncthreads(); phase_p0(F);
#endif
#endif
    grid.sync(); PH();

#pragma unroll 1
    for (int l = 0; l < 4; ++l) {
        const int kind = l % 3;
        if (l == 0) PMOD(true, F, F.in[0], F.in[1] - (size_t)NP * DM, NG, MODSL, 0, false); else PMOD(false, F, X_, X_, NG, MODSL, 0, false);
        SYNC();
        { pg8::Gemm g{U_, (const bf16_t*)WSP(WS_WI) + (size_t)(l * 2) * 2 * DFF * DM, NT, 2 * DFF, DM, DM, DM, 0, 128, 128}; S.init(NT, 2 * DFF, F.G, blockIdx.x);
          EpiSwiglu E{H_};
#ifndef NO_G1
          pg8::gemm_phase(F.lds, g, S, E);
#ifdef PROBE_G1
          pg8::gemm_phase(F.lds, g, S, E);
#endif
#endif
          { const int tail0 = ((NT / 256) * (2 * DFF / 256)) % F.G;
            if (l < 3 && (int)blockIdx.x >= tail0) { const int bi = blockIdx.x - tail0, bc = F.G - tail0;
                adaln_layer(F, l + 1, bi, bc); convert_layer(F, l + 1, 2 * (bi * 8 + F.wave), 2 * bc * 8); } }
        }
        SYNC();
        { pg8::Gemm g{H_, (const bf16_t*)WSP(WS_WO) + (size_t)(l * 2) * DM * DFF, NP, DM, DFF, 64, 64, 0, (size_t)NT * 128, (size_t)DM * 128}; S.init(NP, DM, F.G, blockIdx.x);
          const float* r_gate = MODSL + 2 * DM;
          if (l == 0) RESID(true, false, true, F.in[0], F.in[1] - (size_t)NP * DM, X_, 0.5f, nullptr, nullptr); else RESID(false, false, true, X_, X_, X_, 0.5f, nullptr, nullptr);
        }
        SYNC();
        PMOD(false, F, X_, X_, NG + DM, MODSL, 3, kind == 1);
        SYNC();
        if (kind == 0) {
            const int j = l / 3;
            { pg8::Gemm g{U_, (const bf16_t*)WSP(WS_WLI) + (size_t)j * 2 * DRNN * DM, NT, 2 * DRNN, DM, DM, DM, 0, 128, 128}; S.init(NT, 2 * DRNN, F.G, blockIdx.x);
              EpiLruIn E{(bf16_t*)WSP(WS_GB), (bf16_t*)WSP(WS_XB), F.out + O_CP + (size_t)j * 2 * 3 * DRNN, F.out + O_CS + (size_t)j * 8 * 3 * DRNN};
#ifndef NO_G3
              pg8::gemm_phase(F.lds, g, S, E);
#endif
            }
            SYNC();
#ifndef NO_LRUG
            phase_lru_gates(F, j);
#ifdef PROBE_LRUG
            phase_lru_gates(F, j);
#endif
#endif
            SYNC();
            phase_lru_agg(F);
#ifdef PROBE_LRUA
            phase_lru_agg(F);
#endif
            SYNC();
            phase_lru_apply(F, j);
#ifdef PROBE_LRUP
            phase_lru_apply(F, j);
#endif
            SYNC();
            { pg8::Gemm g{(const bf16_t*)WSP(WS_XB), (const bf16_t*)WSP(WS_WLO) + (size_t)j * DM * DRNN, NP, DM, DRNN, DRNN, DRNN, 0, 128, 128}; S.init(NP, DM, F.G, blockIdx.x);
          const float* r_gate = MODSL + 5 * DM;
          RESID(false, false, false, X_, X_, X_, 1.f, nullptr, nullptr);
            }
        } else if (kind == 1) {
            phase_pool(F);
#ifdef PROBE_POOL
            phase_pool(F);
#endif
            SYNC();
            { pg8::Gemm g{(const bf16_t*)WSP(WS_DP), (const bf16_t*)WSP(WS_WP), NP, DM, 256, DM, 256, 256, 128, 128}; S.init(NP, DM, F.G, blockIdx.x);
          const float* r_gate = MODSL + 5 * DM;
          RESID(false, false, false, X_, X_, X_, 1.f, F.in[24], F.in[25]);
            }
        } else {
            { pg8::Gemm g{U_, (const bf16_t*)WSP(WS_WQKV), NT, 3 * DM, DM, DM, DM, 0, 128, 128}; S.init(NT, 3 * DM, F.G, blockIdx.x);
              EpiQKV E{(bf16_t*)WSP(WS_QB), (bf16_t*)WSP(WS_KB), (bf16_t*)WSP(WS_VT), (bf16_t*)WSP(WS_KBS), (bf16_t*)WSP(WS_VTS), F.out, F.in[27], F.in[28]};
#ifndef NO_G4
              pg8::gemm_phase(F.lds, g, S, E);
#endif
            }
            SYNC();
#ifndef NO_ATTN
            phase_attn(F);
#ifdef PROBE_ATTN
            phase_attn(F);
#endif
#endif
            SYNC();
            { pg8::Gemm g{(const bf16_t*)WSP(WS_OB), (const bf16_t*)WSP(WS_WAO), NP, DM, DM, DM, DM, 0, 128, 128}; S.init(NP, DM, F.G, blockIdx.x);
          const float* r_gate = MODSL + 5 * DM;
          RESID(false, false, false, X_, X_, X_, 1.f, nullptr, nullptr);
            }
        }
        SYNC();
        PMOD(false, F, X_, X_, NG + 2 * DM, MODSL, 6, false);
        SYNC();
        { pg8::Gemm g{U_, (const bf16_t*)WSP(WS_WI) + (size_t)(l * 2 + 1) * 2 * DFF * DM, NT, 2 * DFF, DM, DM, DM, 0, 128, 128}; S.init(NT, 2 * DFF, F.G, blockIdx.x);
          EpiSwiglu E{H_};
#ifndef NO_G1
          pg8::gemm_phase(F.lds, g, S, E);
#ifdef PROBE_G1
          pg8::gemm_phase(F.lds, g, S, E);
#endif
#endif
                  { const int tail0 = ((NT / 256) * (2 * DFF / 256)) % F.G;
            if (l < 3 && (int)blockIdx.x >= tail0) { const int bi = blockIdx.x - tail0, bc = F.G - tail0;
                convert_layer(F, l + 1, 2 * (bi * 8 + F.wave) + 1, 2 * bc * 8); } }
        }
        SYNC();
        { pg8::Gemm g{H_, (const bf16_t*)WSP(WS_WO) + (size_t)(l * 2 + 1) * DM * DFF, NP, DM, DFF, 64, 64, 0, (size_t)NT * 128, (size_t)DM * 128}; S.init(NP, DM, F.G, blockIdx.x);
          const float* r_gate = MODSL + 8 * DM;
          if (l == 3) RESID(false, true, true, X_, X_, F.out + O_Y, 0.5f, nullptr, nullptr); else RESID(false, false, true, X_, X_, X_, 0.5f, nullptr, nullptr);
        }
        SYNC();
    }
}

extern "C" void kernel_launch(void* const* d_in, const int* in_sizes, int n_in, void* d_out, int out_size, void* d_ws, size_t ws_size, hipStream_t stream) {
    static int grid = 0;
    if (grid == 0) {
        if (n_in != 33 || out_size != (int)O_END || ws_size < WS_END) { fprintf(stderr, "kernel_launch: unexpected shapes (n_in %d out %d ws %zu)\n", n_in, out_size, ws_size); grid = -1; return; }
        int dev = 0, cus = 0, per_cu = 0;
        (void)hipGetDevice(&dev); (void)hipDeviceGetAttribute(&cus, hipDeviceAttributeMultiprocessorCount, dev);
        (void)hipFuncSetAttribute((const void*)fwd_megakernel, hipFuncAttributeMaxDynamicSharedMemorySize, LDS_BYTES);
        (void)hipOccupancyMaxActiveBlocksPerMultiprocessor(&per_cu, (const void*)fwd_megakernel, 512, LDS_BYTES);
        if (per_cu < 1) { fprintf(stderr, "kernel_launch: occupancy query says %d blocks/CU\n", per_cu); per_cu = 1; }
        (void)hipGetLastError();
        grid = cus;
    }
    if (grid < 0) return;
    (void)hipMemsetAsync(d_ws, 0, 65536, stream);
    Params p{};
    for (int i = 0; i < 33; ++i) p.in[i] = (const float*)d_in[i];
    p.out = (float*)d_out; p.ws = (unsigned char*)d_ws;
    void* args[] = {&p};
    hipError_t e = hipLaunchCooperativeKernel((const void*)fwd_megakernel, dim3(grid), dim3(512), args, LDS_BYTES, stream);
    if (e != hipSuccess) fprintf(stderr, "cooperative launch failed: %s (grid %d)\n", hipGetErrorString(e), grid);
}
```

```cpp
#include <hip/hip_runtime.h>
#include <hip/hip_cooperative_groups.h>
#include <cstdio>
#include <cstdint>
namespace cg = cooperative_groups;

#define LAS __attribute__((address_space(3)))
typedef unsigned short bf16_t;
typedef short bf16x8 __attribute__((ext_vector_type(8)));
typedef short s16x4 __attribute__((ext_vector_type(4)));
typedef float f32x4 __attribute__((ext_vector_type(4)));
typedef float f32x16 __attribute__((ext_vector_type(16)));
typedef unsigned u32x4 __attribute__((ext_vector_type(4)));
typedef unsigned u32x2 __attribute__((ext_vector_type(2)));
#define DI __device__ __forceinline__
#define GAS __attribute__((address_space(1)))

constexpr int DM = 1024, NP = 16384, NS = 256, NT = NP + NS, SEQ = 8192, DSEQ = 32, NSEQ = 10;
constexpr int DFF = 2816, DRNN = 1280, PAST = 1024, TPS = 1088  , KVS = 1056;
constexpr int MODW = 9 * DM;
constexpr float EPS = 1e-6f;
constexpr float LOG2E = 1.4426950408889634f;
constexpr float QSC = 0.125f * LOG2E;
constexpr float LAM_INIT = 0.47071301834f;
constexpr size_t O_Y = 0, O_HP = 17039360, O_HS = 17044480, O_CP = 17064960, O_CS = 17080320, O_PP = 17141760, O_PS = 17172480,
                 O_KP = 17295360, O_VP = 34072576, O_KS = 50849792, O_VS = 51111936, O_END = 51374080;
constexpr size_t MiB = 1u << 20;
constexpr size_t WS_SPL = 512 * 1024  , WS_MODS = 1 * MiB, WS_WG = 3 * MiB, WS_AGG = 4 * MiB, WS_WI = 8 * MiB, WS_WO = 96 * MiB, WS_WLI = 140 * MiB, WS_WLO = 150 * MiB,
                 WS_WP = 155 * MiB, WS_WQKV = 156 * MiB, WS_WAO = 162 * MiB, WS_X = 164 * MiB, WS_U = 229 * MiB, WS_H = 262 * MiB,
                 WS_GB = 262 * MiB, WS_XB = 304 * MiB, WS_A = 352 * MiB, WS_BN = 434 * MiB,
                 WS_DP = 262 * MiB, WS_QB = 262 * MiB, WS_OB = 296 * MiB, WS_KB = 352 * MiB, WS_VT = 384 * MiB,
                 WS_KBS = 516 * MiB, WS_VTS = 533 * MiB, WS_END = 550 * MiB;
constexpr int LDS_BYTES = 147456;

DI unsigned cvt_pk_bf16(float lo, float hi) { unsigned r; asm volatile("v_cvt_pk_bf16_f32 %0, %1, %2" : "=v"(r) : "v"(lo), "v"(hi)); return r; }
DI float bf2f(unsigned short b) { return __uint_as_float(((unsigned)b) << 16); }
DI float bflo(unsigned w) { return __uint_as_float(w << 16); }
DI float bfhi(unsigned w) { return __uint_as_float(w & 0xffff0000u); }
DI int seq_of_row(int r) { return r < NP ? (r >> 13) : 2 + ((r - NP) >> 5); }
DI int pos_of_row(int r) { return r < NP ? (r & (SEQ - 1)) : ((r - NP) & (DSEQ - 1)); }
DI float wave_sum(float v) {
#pragma unroll
    for (int o = 1; o < 64; o <<= 1) v += __shfl_xor(v, o);
    return v;
}
DI float wave_max(float v) {
#pragma unroll
    for (int o = 1; o < 64; o <<= 1) v = fmaxf(v, __shfl_xor(v, o));
    return v;
}
DI float sigmoidf_(float x) { return __builtin_amdgcn_rcpf(1.f + __expf(-x)); }
DI float gelu_tanh(float x) { const float u = 0.7978845608028654f * (x + 0.044715f * x * x * x); const float t = 1.f - 2.f * __builtin_amdgcn_rcpf(1.f + __expf(2.f * u)); return 0.5f * x * (1.f + t); }

namespace pg8 {
constexpr int BM = 256, BK = 64, HALF = 128, HTB = HALF * BK * 2, STAGE_BYTES = 8 * HTB, NXCD = 8, WGM = 8;
DI int lds_byte(int r, int c) { const int st = (r >> 4) * 2 + (c >> 5), rr = r & 15, cc = c & 31, ob = rr * 64 + cc * 2; return st * 1024 + (ob ^ (((ob >> 9) & 1) << 5)); }
DI void stage_rc(int b, int& R, int& C) { const int st = b / 1024, sb = b % 1024, swz = sb ^ (((sb >> 9) & 1) << 5); R = (st >> 1) * 16 + swz / 64; C = (st & 1) * 32 + (swz % 64) / 2; }
DI int perm32(int rho) { const int n = rho >> 4, i = rho & 15; return 8 * (i >> 2) + 4 * n + (i & 3); }
struct Unit { int pm, pn; };
struct Gemm { const bf16_t* A; const bf16_t* Bt; int M, N, K, lda, ldb, a_pn_off; size_t kstepA, kstepB; };
struct StaticOrder {
    int nM, nN, nwg, G, c;
    DI void init(int M, int N, int G_, int c_) { nM = M / BM; nN = N / BM; nwg = nM * nN; G = G_; c = c_; }
    DI bool next(int i, Unit& u) const {
        const long L = (long)i * G + c; if (L >= nwg) return false;
        int wgid = (int)L; { const int q = nwg / NXCD, r = nwg % NXCD, xcd = wgid % NXCD, off = wgid / NXCD; wgid = (xcd < r ? xcd * (q + 1) : r * (q + 1) + (xcd - r) * q) + off; }
        const int nig = WGM * nN, gid = wgid / nig, fm = gid * WGM, gsz = (nM - fm) < WGM ? (nM - fm) : WGM;
        u.pm = fm + ((wgid % nig) % gsz); u.pn = (wgid % nig) / gsz; return true;
    }
};
template <class Epi>
DI void gemm_phase(LAS unsigned char* lds, const Gemm g, const StaticOrder& S, const Epi& E) {
    int tid_ = threadIdx.x; asm volatile("" : "+v"(tid_));
    const int tid = tid_, wid = __builtin_amdgcn_readfirstlane(tid >> 6), lane = tid & 63, wr = wid >> 2, wc = wid & 3, fr = lane & 15, fq = lane >> 4;
    const int K = g.K, nt = K / BK;
    unsigned voffA[2], voffB[2];
#pragma unroll
    for (int i = 0; i < 2; ++i) { int R, C; stage_rc(tid * 16 + i * 8192, R, C); const int Rb = (R & ~31) + perm32(R & 31);
        voffA[i] = (unsigned)(R * g.lda + C) * 2u; voffB[i] = (unsigned)(Rb * g.ldb + C) * 2u; }
    const size_t kstepA = g.kstepA, kstepB = g.kstepB;
    const size_t hstepA = (size_t)HALF * g.lda * 2, hstepB = (size_t)HALF * g.ldb * 2;
    const size_t tstepA = 2 * hstepA, tstepB = 2 * hstepB;
    const unsigned ldsw = (unsigned)wid * 1024u;
    const int aoff = lds_byte(wr * 64 + fr, fq * 8), boff = lds_byte(wc * 32 + fr, fq * 8);
#define PG8_SA(b, h) (((b) * 2 + (h)) * HTB)
#define PG8_SB(b, h) ((4 + (b) * 2 + (h)) * HTB)
#define PG8_STAGE(bufoff, gbase, voff) do { _Pragma("unroll") for (int _i = 0; _i < 2; ++_i) \
        __builtin_amdgcn_global_load_lds((const unsigned*)((const char*)(gbase) + (voff)[_i]), (LAS unsigned*)(lds + (bufoff) + ldsw + _i * 8192), 16, 0, 0); } while (0)
#define PG8_LDA(dst, b, h) do { _Pragma("unroll") for (int m = 0; m < 4; ++m) _Pragma("unroll") for (int k = 0; k < 2; ++k) dst[m][k] = *(const LAS bf16x8*)(lds + PG8_SA(b, h) + aoff + m * 2048 + k * 1024); } while (0)
#define PG8_LDB(dst, b, h) do { _Pragma("unroll") for (int n = 0; n < 2; ++n) _Pragma("unroll") for (int k = 0; k < 2; ++k) dst[n][k] = *(const LAS bf16x8*)(lds + PG8_SB(b, h) + boff + n * 2048 + k * 1024); } while (0)
#define PG8_MMA(ai, bj, At, Bt) do { __builtin_amdgcn_s_setprio(1); _Pragma("unroll") for (int m = 0; m < 4; ++m) _Pragma("unroll") for (int n = 0; n < 2; ++n) _Pragma("unroll") for (int k = 0; k < 2; ++k) \
        acc[ai][bj][m][n] = __builtin_amdgcn_mfma_f32_16x16x32_bf16(Bt[n][k], At[m][k], acc[ai][bj][m][n], 0, 0, 0); __builtin_amdgcn_s_setprio(0); } while (0)
#define PG8_WAIT_V(n) asm volatile("s_waitcnt vmcnt(" #n ")" ::: "memory")
#define PG8_WAIT_L(n) asm volatile("s_waitcnt lgkmcnt(" #n ")" ::: "memory")
#define PG8_BAR __builtin_amdgcn_s_barrier()
#define PG8_SCHED __builtin_amdgcn_sched_barrier(0)
    Unit cur, nxt; int ui = 0;
    if (!S.next(0, cur)) return;
    f32x4 acc[2][2][4][2];
#pragma unroll
    for (int a = 0; a < 2; ++a)
#pragma unroll
        for (int b = 0; b < 2; ++b)
#pragma unroll
            for (int m = 0; m < 4; ++m)
#pragma unroll
                for (int n = 0; n < 2; ++n) acc[a][b][m][n] = (f32x4){0.f, 0.f, 0.f, 0.f};
    bf16x8 At[4][2], B0[2][2], B1[2][2];
    const char* cA = (const char*)g.A + (size_t)cur.pm * tstepA + (size_t)cur.pn * g.a_pn_off * 2; const char* cB = (const char*)g.Bt + (size_t)cur.pn * tstepB;
    PG8_STAGE(PG8_SB(0, 0), cB, voffB); PG8_STAGE(PG8_SB(0, 1), cB + hstepB, voffB); PG8_STAGE(PG8_SA(0, 0), cA, voffA); PG8_STAGE(PG8_SA(0, 1), cA + hstepA, voffA);
    if (wr == 1) PG8_BAR;
    PG8_WAIT_V(2); PG8_BAR;
    PG8_STAGE(PG8_SB(1, 0), cB + kstepB, voffB); PG8_STAGE(PG8_SA(1, 0), cA + kstepA, voffA); PG8_STAGE(PG8_SB(1, 1), cB + hstepB + kstepB, voffB);
    PG8_WAIT_V(6); PG8_BAR;
    for (;;) {
        const bool has_next = S.next(ui + 1, nxt);
        const char* nA = has_next ? (const char*)g.A + (size_t)nxt.pm * tstepA + (size_t)nxt.pn * g.a_pn_off * 2 : cA; const char* nB = has_next ? (const char*)g.Bt + (size_t)nxt.pn * tstepB : cB;
        for (int t = 0; t < nt; t += 2) {
            const bool last = (t == nt - 2);
            const char* a1 = cA + (size_t)(t + 1) * kstepA;
            const char* a2 = last ? nA : cA + (size_t)(t + 2) * kstepA; const char* b2 = last ? nB : cB + (size_t)(t + 2) * kstepB;
            const char* a3 = a2 + kstepA; const char* b3 = b2 + kstepB;
            PG8_LDB(B0, 0, 0); PG8_LDB(B1, 0, 1); PG8_SCHED; PG8_LDA(At, 0, 0); PG8_STAGE(PG8_SA(1, 1), a1 + hstepA, voffA);
            PG8_WAIT_V(8); PG8_WAIT_L(0); PG8_BAR; PG8_MMA(0, 0, At, B0); PG8_MMA(0, 1, At, B1); PG8_BAR; PG8_SCHED;
            PG8_LDA(At, 0, 1); PG8_STAGE(PG8_SB(0, 0), b2, voffB); PG8_STAGE(PG8_SB(0, 1), b2 + hstepB, voffB); PG8_STAGE(PG8_SA(0, 0), a2, voffA);
            PG8_WAIT_V(8); PG8_WAIT_L(0); PG8_BAR; PG8_MMA(1, 0, At, B0); PG8_MMA(1, 1, At, B1); PG8_BAR; PG8_SCHED;
            PG8_LDB(B0, 1, 0); PG8_LDB(B1, 1, 1); PG8_SCHED; PG8_LDA(At, 1, 0); PG8_STAGE(PG8_SA(0, 1), a2 + hstepA, voffA);
            PG8_WAIT_V(8); PG8_WAIT_L(0); PG8_BAR; PG8_MMA(0, 0, At, B0); PG8_MMA(0, 1, At, B1); PG8_BAR; PG8_SCHED;
            PG8_LDA(At, 1, 1); PG8_STAGE(PG8_SB(1, 0), b3, voffB); PG8_STAGE(PG8_SB(1, 1), b3 + hstepB, voffB); PG8_STAGE(PG8_SA(1, 0), a3, voffA);
            PG8_WAIT_V(8); PG8_WAIT_L(0); PG8_BAR; PG8_MMA(1, 0, At, B0); PG8_MMA(1, 1, At, B1); PG8_BAR; PG8_SCHED;
        }
        if (wr == 0) PG8_BAR;
        E(acc, cur, wr, wc, fr, fq);
        if (!has_next) break;
#pragma unroll
        for (int a = 0; a < 2; ++a)
#pragma unroll
            for (int b = 0; b < 2; ++b)
#pragma unroll
                for (int m = 0; m < 4; ++m)
#pragma unroll
                    for (int n = 0; n < 2; ++n) acc[a][b][m][n] = (f32x4){0.f, 0.f, 0.f, 0.f};
        cur = nxt; cA = nA; cB = nB; ++ui;
        if (wr == 1) PG8_BAR;
    }
    PG8_WAIT_V(0);
    PG8_BAR;
#undef PG8_SA
#undef PG8_SB
#undef PG8_STAGE
#undef PG8_LDA
#undef PG8_LDB
#undef PG8_MMA
#undef PG8_WAIT_V
#undef PG8_WAIT_L
#undef PG8_BAR
#undef PG8_SCHED
}
}

struct Params { const float* in[33]; float* out; unsigned char* ws; };
constexpr int PTAB_OFF = 143360;
struct InTab { LAS unsigned char* lds;
    DI const float* operator[](int i) const { const unsigned long long v = *(volatile LAS unsigned long long*)(lds + PTAB_OFF + 8 * i);
        const unsigned lo = __builtin_amdgcn_readfirstlane((unsigned)v), hi = __builtin_amdgcn_readfirstlane((unsigned)(v >> 32)); return (const float*)(((unsigned long long)hi << 32) | lo); } };
struct Frame {
    LAS unsigned char* lds; int tid, lane, wave, G, gw, NGW, gtid, GT;
    InTab in; float* out; unsigned char* ws;
};
typedef pg8::Unit Unit;
typedef f32x4 Acc[2][2][4][2];

struct EpiSwiglu {
    bf16_t* H;
    DI void operator()(const Acc& acc, const Unit& u, int wr, int wc, int fr, int fq) const {
        asm volatile("" : "+v"(fr), "+v"(fq));
#pragma unroll
        for (int ai = 0; ai < 2; ++ai)
#pragma unroll
            for (int m = 0; m < 4; ++m) { const int row = u.pm * 256 + ai * 128 + wr * 64 + m * 16 + fr;
#pragma unroll
                for (int bj = 0; bj < 2; ++bj) { const int j0 = u.pn * 128 + bj * 64 + wc * 16 + 4 * fq; const f32x4 v0 = acc[ai][bj][m][0], v1 = acc[ai][bj][m][1];
                    const float h0 = v0[0] * sigmoidf_(v0[0]) * v0[1], h1 = v0[2] * sigmoidf_(v0[2]) * v0[3], h2 = v1[0] * sigmoidf_(v1[0]) * v1[1], h3 = v1[2] * sigmoidf_(v1[2]) * v1[3];
                    u32x2 w; w.x = cvt_pk_bf16(h0, h1); w.y = cvt_pk_bf16(h2, h3);
                    *(u32x2*)(H + (size_t)(j0 >> 6) * NT * 64 + (size_t)row * 64 + (j0 & 63)) = w; }
                asm volatile("" ::: "memory"); }
    }
};
template <bool XI32, bool XO32> struct EpiResidT {
    const void* xiP; const void* xiS; void* xo; const float* gate; float gsc; const float* pb; const float* ps;
    DI void operator()(const Acc& acc, const Unit& u, int wr, int wc, int fr, int fq) const {
        asm volatile("" : "+v"(fr), "+v"(fq));
#pragma unroll
        for (int ai = 0; ai < 2; ++ai)
#pragma unroll
            for (int m = 0; m < 4; ++m) { const int row = u.pm * 256 + ai * 128 + wr * 64 + m * 16 + fr; const int seq = seq_of_row(row);
                const float* gr = gate + (size_t)seq * MODW;
                const int colb = u.pn * 256 + wc * 32 + 8 * fq;
                f32x4 xv[2][2], gt[2][2];
#pragma unroll
                for (int bj = 0; bj < 2; ++bj) { const int c = colb + bj * 128;
                    if constexpr (XI32) { const float* xi = (const float*)xiP + (size_t)row * DM + c; xv[bj][0] = *(const f32x4*)xi; xv[bj][1] = *(const f32x4*)(xi + 4); }
                    else { const u32x4 q = *(const u32x4*)((const bf16_t*)xiP + (size_t)row * DM + c);
                        xv[bj][0] = (f32x4){bflo(q.x), bfhi(q.x), bflo(q.y), bfhi(q.y)}; xv[bj][1] = (f32x4){bflo(q.z), bfhi(q.z), bflo(q.w), bfhi(q.w)}; }
                    gt[bj][0] = *(const f32x4*)(gr + c); gt[bj][1] = *(const f32x4*)(gr + c + 4); }
#pragma unroll
                for (int bj = 0; bj < 2; ++bj) { const int c = colb + bj * 128; f32x4 o[2];
#pragma unroll
                    for (int n = 0; n < 2; ++n) { f32x4 v = acc[ai][bj][m][n];
                        if (pb) { v = (v + *(const f32x4*)(pb + c + 4 * n)) * *(const f32x4*)(ps + c + 4 * n); }
                        o[n] = xv[bj][n] + gsc * gt[bj][n] * v; }
                    if constexpr (XO32) { float* xr = (float*)xo + (size_t)row * DM + c; *(f32x4*)xr = o[0]; *(f32x4*)(xr + 4) = o[1]; }
                    else { u32x4 w; w.x = cvt_pk_bf16(o[0][0], o[0][1]); w.y = cvt_pk_bf16(o[0][2], o[0][3]); w.z = cvt_pk_bf16(o[1][0], o[1][1]); w.w = cvt_pk_bf16(o[1][2], o[1][3]);
                        *(u32x4*)((bf16_t*)xo + (size_t)row * DM + c) = w; } }
                asm volatile("" ::: "memory"); }
    }
};
struct EpiLruIn {
    bf16_t* GB; bf16_t* XB; float* convP; float* convS;
    DI void operator()(const Acc& acc, const Unit& u, int wr, int wc, int fr, int fq) const {
        asm volatile("" : "+v"(fr), "+v"(fq));
        const bool isx = u.pn >= 5;
#pragma unroll
        for (int ai = 0; ai < 2; ++ai)
#pragma unroll
            for (int m = 0; m < 4; ++m) { const int row = u.pm * 256 + ai * 128 + wr * 64 + m * 16 + fr;
#pragma unroll
                for (int bj = 0; bj < 2; ++bj) { const int col = u.pn * 256 + bj * 128 + wc * 32 + 8 * fq; f32x4 v0 = acc[ai][bj][m][0], v1 = acc[ai][bj][m][1];
                    if (!isx) {
#pragma unroll
                        for (int e = 0; e < 4; ++e) { v0[e] = gelu_tanh(v0[e]); v1[e] = gelu_tanh(v1[e]); }
                    }
                    u32x4 w; w.x = cvt_pk_bf16(v0[0], v0[1]); w.y = cvt_pk_bf16(v0[2], v0[3]); w.z = cvt_pk_bf16(v1[0], v1[1]); w.w = cvt_pk_bf16(v1[2], v1[3]);
                    if (!isx) *(u32x4*)(GB + (size_t)row * DRNN + col) = w;
                    else { const int c = col - DRNN; *(u32x4*)(XB + (size_t)row * DRNN + c) = w;
                        const int pos = pos_of_row(row), seq = seq_of_row(row); const int tl = row < NP ? SEQ : DSEQ;
                        if (pos >= tl - 3) { float* o = (row < NP ? convP + ((size_t)seq * 3 + (pos - (tl - 3))) * DRNN : convS + ((size_t)(seq - 2) * 3 + (pos - (tl - 3))) * DRNN) + c;
                            *(f32x4*)o = v0; *(f32x4*)(o + 4) = v1; } } }
                asm volatile("" ::: "memory"); }
    }
};
struct EpiQKV {
    bf16_t* Qb; bf16_t* Kb; bf16_t* Vt; bf16_t* Kbs; bf16_t* Vts; float* out; const float* qg; const float* kg;
    DI void operator()(const Acc& acc, const Unit& u, int wr, int wc, int fr, int fq) const {
        asm volatile("" : "+v"(fr), "+v"(fq));
        const int sg = 4 * u.pn + wc, typ = sg >> 4, s16 = sg & 15;
        const float* g = typ == 0 ? qg : kg;
        f32x4 gv[2][2];
        if (typ < 2) {
#pragma unroll
            for (int bj = 0; bj < 2; ++bj)
#pragma unroll
                for (int n = 0; n < 2; ++n) gv[bj][n] = *(const f32x4*)(g + 32 * bj + 8 * fq + 4 * n);
        }
#pragma unroll
        for (int ai = 0; ai < 2; ++ai)
#pragma unroll
            for (int m = 0; m < 4; ++m) { const int row = u.pm * 256 + ai * 128 + wr * 64 + m * 16 + fr;
                if (typ < 2) {
                    float ss = 0.f;
#pragma unroll
                    for (int bj = 0; bj < 2; ++bj)
#pragma unroll
                        for (int n = 0; n < 2; ++n) { const f32x4 x = acc[ai][bj][m][n]; ss += (x[0] * x[0] + x[1] * x[1]) + (x[2] * x[2] + x[3] * x[3]); }
                    ss += __shfl_xor(ss, 16); ss += __shfl_xor(ss, 32);
                    const float rstd = __builtin_amdgcn_rsqf(ss * (1.f / 64.f) + EPS);
#pragma unroll
                    for (int bj = 0; bj < 2; ++bj) { const int c = 64 * s16 + 32 * bj + 8 * fq;
                        f32x4 y0 = acc[ai][bj][m][0] * rstd * gv[bj][0], y1 = acc[ai][bj][m][1] * rstd * gv[bj][1];
                        if (typ == 0) { y0 = y0 * QSC; y1 = y1 * QSC;
                            u32x4 w; w.x = cvt_pk_bf16(y0[0], y0[1]); w.y = cvt_pk_bf16(y0[2], y0[3]); w.z = cvt_pk_bf16(y1[0], y1[1]); w.w = cvt_pk_bf16(y1[2], y1[3]);
                            *(u32x4*)(Qb + (size_t)row * DM + c) = w;
                        } else {
                            u32x4 w; w.x = cvt_pk_bf16(y0[0], y0[1]); w.y = cvt_pk_bf16(y0[2], y0[3]); w.z = cvt_pk_bf16(y1[0], y1[1]); w.w = cvt_pk_bf16(y1[2], y1[3]);
                            float* ko; bf16_t* kb;
                            if (row < NP) { ko = out + O_KP + (size_t)row * DM + c; kb = Kb + (size_t)row * DM + c; }
                            else { const int r2 = row - NP; ko = out + O_KS + (size_t)r2 * DM + c; kb = Kbs + ((size_t)(r2 >> 5) * TPS + PAST + (r2 & 31)) * DM + c; }
                            *(f32x4*)ko = y0; *(f32x4*)(ko + 4) = y1; *(u32x4*)kb = w; } }
                } else {
#pragma unroll
                    for (int bj = 0; bj < 2; ++bj) { const int c = 64 * s16 + 32 * bj + 8 * fq; const f32x4 y0 = acc[ai][bj][m][0], y1 = acc[ai][bj][m][1];
                        float* vo; bf16_t* vt; size_t tp;
                        if (row < NP) { vo = out + O_VP + (size_t)row * DM + c; tp = SEQ; vt = Vt + ((size_t)(row >> 13) * DM + c) * SEQ + (row & (SEQ - 1)); }
                        else { const int r2 = row - NP; vo = out + O_VS + (size_t)r2 * DM + c; tp = TPS; vt = Vts + ((size_t)(r2 >> 5) * DM + c) * TPS + PAST + (r2 & 31); }
                        *(f32x4*)vo = y0; *(f32x4*)(vo + 4) = y1;
                        const unsigned w0 = cvt_pk_bf16(y0[0], y0[1]), w1 = cvt_pk_bf16(y0[2], y0[3]), w2 = cvt_pk_bf16(y1[0], y1[1]), w3 = cvt_pk_bf16(y1[2], y1[3]);
                        vt[0] = (bf16_t)w0; vt[tp] = (bf16_t)(w0 >> 16); vt[2 * tp] = (bf16_t)w1; vt[3 * tp] = (bf16_t)(w1 >> 16);
                        vt[4 * tp] = (bf16_t)w2; vt[5 * tp] = (bf16_t)(w2 >> 16); vt[6 * tp] = (bf16_t)w3; vt[7 * tp] = (bf16_t)(w3 >> 16); } }
                asm volatile("" ::: "memory"); }
    }
};

template <bool SLAB, bool XI32, bool XO32>
DI void small_gemm_resid(const Frame& F, const bf16_t* A, int lda, int a_grp_off, const bf16_t* Bt, int K, const void* e_xiS, void* e_xo, const float* e_gate, float e_gsc, const float* e_pb, const float* e_ps) {
    const int fr = F.lane & 15, fq = F.lane >> 4;
    LAS float* red = (LAS float*)F.lds;
    const int ksl = K >> 3, nks = ksl >> 5;
#pragma unroll 1
    for (int t = blockIdx.x; t < 256; t += F.G) {
        const int rt = t >> 5, ct = t & 31; const int r0 = NP + 32 * rt, c0 = 32 * ct;
        const int kl = F.wave * ksl + 8 * fq;
        const bf16_t* ap = SLAB ? A + (size_t)(r0 + fr) * 64 : A + (size_t)(r0 + fr) * lda + (c0 >> 8) * a_grp_off + kl;
        const bf16_t* bp = SLAB ? Bt + (size_t)(c0 + fr) * 64 : Bt + (size_t)(c0 + fr) * K + kl;
        f32x4 acc[2][2];
#pragma unroll
        for (int j = 0; j < 2; ++j)
#pragma unroll
            for (int i = 0; i < 2; ++i) acc[j][i] = (f32x4){0.f, 0.f, 0.f, 0.f};
#pragma unroll 4
        for (int ks = 0; ks < nks; ++ks) {
            const int k = kl + 32 * ks;
            const size_t ao = SLAB ? (size_t)(k >> 6) * NT * 64 + (k & 63) : (size_t)(32 * ks), bo = SLAB ? (size_t)(k >> 6) * DM * 64 + (k & 63) : (size_t)(32 * ks);
            const size_t a16 = SLAB ? (size_t)16 * 64 : (size_t)16 * lda, b16 = SLAB ? (size_t)16 * 64 : (size_t)16 * K;
            const bf16x8 a0 = *(const bf16x8*)(ap + ao), a1 = *(const bf16x8*)(ap + ao + a16);
            const bf16x8 b0 = *(const bf16x8*)(bp + bo), b1 = *(const bf16x8*)(bp + bo + b16);
            acc[0][0] = __builtin_amdgcn_mfma_f32_16x16x32_bf16(b0, a0, acc[0][0], 0, 0, 0); acc[0][1] = __builtin_amdgcn_mfma_f32_16x16x32_bf16(b0, a1, acc[0][1], 0, 0, 0);
            acc[1][0] = __builtin_amdgcn_mfma_f32_16x16x32_bf16(b1, a0, acc[1][0], 0, 0, 0); acc[1][1] = __builtin_amdgcn_mfma_f32_16x16x32_bf16(b1, a1, acc[1][1], 0, 0, 0);
        }
#pragma unroll
        for (int j = 0; j < 2; ++j)
#pragma unroll
            for (int i = 0; i < 2; ++i)
#pragma unroll
                for (int e = 0; e < 4; ++e) red[(F.wave * 32 + 16 * i + fr) * 33 + 16 * j + 4 * fq + e] = acc[j][i][e];
        __syncthreads();
        { const int m = F.tid >> 4, n0 = (F.tid & 15) * 2; float v0 = 0.f, v1 = 0.f;
#pragma unroll
          for (int w = 0; w < 8; ++w) { v0 += red[(w * 32 + m) * 33 + n0]; v1 += red[(w * 32 + m) * 33 + n0 + 1]; }
          const int row = r0 + m, col = c0 + n0; const int seq = seq_of_row(row);
          if (e_pb) { v0 = (v0 + e_pb[col]) * e_ps[col]; v1 = (v1 + e_pb[col + 1]) * e_ps[col + 1]; }
          const float* gr = e_gate + (size_t)seq * MODW + col; float x0, x1;
          if constexpr (XI32) { const float* xi = (const float*)e_xiS + (size_t)row * DM + col; x0 = xi[0]; x1 = xi[1]; }
          else { const unsigned q = *(const unsigned*)((const bf16_t*)e_xiS + (size_t)row * DM + col); x0 = bflo(q); x1 = bfhi(q); }
          const float o0 = x0 + e_gsc * gr[0] * v0, o1 = x1 + e_gsc * gr[1] * v1;
          if constexpr (XO32) { float* xo = (float*)e_xo + (size_t)row * DM + col; xo[0] = o0; xo[1] = o1; }
          else *(unsigned*)((bf16_t*)e_xo + (size_t)row * DM + col) = cvt_pk_bf16(o0, o1); }
        __syncthreads();
    }
}

DI int dst_row(int mode, int n) {
    if (mode == 1) return n < DFF ? 2 * n : 2 * (n - DFF) + 1;
    if (mode == 2) { const int sg = n >> 6, e = n & 63; return ((sg >> 2) << 8) + ((e >> 5) << 7) + ((sg & 3) << 5) + (e & 31); }
    return n;
}
DI void transpose_item(const float* W, int K, int N, bf16_t* WT, int mode, LAS float* scr, int item, int lane) {
    const int nblk = N / 32, kb = item / nblk, nb = item % nblk, k0 = 64 * kb, n0 = 32 * nb;
    const float* wp_ = W + (size_t)(k0 + (lane >> 5)) * N + n0 + (lane & 31); const size_t wst = 2 * (size_t)N;
    { float wv[32];
#pragma unroll
        for (int i = 0; i < 32; ++i) { wv[i] = __builtin_nontemporal_load(wp_); wp_ += wst; }
#pragma unroll
        for (int i = 0; i < 32; ++i) scr[(2 * i + (lane >> 5)) * 33 + (lane & 31)] = wv[i]; }
    asm volatile("s_waitcnt lgkmcnt(0)" ::: "memory");
    const int c = lane & 7;
#pragma unroll
    for (int j = 0; j < 4; ++j) { const int n = (lane >> 3) + 8 * j; const LAS float* s = scr + (8 * c) * 33 + n;
        u32x4 o; o.x = cvt_pk_bf16(s[0 * 33], s[1 * 33]); o.y = cvt_pk_bf16(s[2 * 33], s[3 * 33]); o.z = cvt_pk_bf16(s[4 * 33], s[5 * 33]); o.w = cvt_pk_bf16(s[6 * 33], s[7 * 33]);
        if (mode == 3) *(u32x4*)(WT + (size_t)kb * N * 64 + (size_t)(n0 + n) * 64 + 8 * c) = o;
        else *(u32x4*)(WT + (size_t)dst_row(mode, n0 + n) * K + k0 + 8 * c) = o; }
    asm volatile("s_waitcnt lgkmcnt(0)" ::: "memory");
}
DI void adaln_layer(const Frame& F, int l, int b_idx, int b_cnt) {
    LAS float* sc = (LAS float*)F.lds; LAS float* part = sc + NSEQ * DM;
    const float* cp = F.in[2]; const float* cs = F.in[3]; const float* adab = F.in[10];
    for (int i = F.tid; i < NSEQ * DM; i += 512) { const int s = i >> 10, k = i & 1023; const float c = s < 2 ? cp[s * DM + k] : cs[(s - 2) * DM + k]; sc[i] = c / (1.f + __expf(-c)); }
    __syncthreads();
    float* MODS = (float*)(F.ws + WS_MODS);
#pragma unroll 1
    for (int task = b_idx; task < 144; task += b_cnt) {
        const int n0 = task * 64;
        const float* W = F.in[9] + (size_t)l * DM * MODW + n0 + F.lane;
        float acc[NSEQ];
#pragma unroll
        for (int s = 0; s < NSEQ; ++s) acc[s] = 0.f;
        const int k0 = F.wave * 128;
        const float* wp_ = W + (size_t)k0 * MODW;
#pragma unroll 1
        for (int kb = k0; kb < k0 + 128; kb += 16) {
            float wv[16];
#pragma unroll
            for (int i = 0; i < 16; ++i) { wv[i] = __builtin_nontemporal_load(wp_); wp_ += MODW; }
#pragma unroll
            for (int i = 0; i < 16; i += 4) {
#pragma unroll
                for (int s = 0; s < NSEQ; ++s) { const f32x4 c4 = *(const LAS f32x4*)(sc + s * DM + kb + i); acc[s] += (c4[0] * wv[i] + c4[1] * wv[i + 1]) + (c4[2] * wv[i + 2] + c4[3] * wv[i + 3]); } }
        }
#pragma unroll
        for (int s = 0; s < NSEQ; ++s) part[(F.wave * NSEQ + s) * 64 + F.lane] = acc[s];
        __syncthreads();
        for (int o = F.tid; o < NSEQ * 64; o += 512) { const int s = o >> 6, ln = o & 63; float sum = 0.f;
#pragma unroll
            for (int w = 0; w < 8; ++w) sum += part[(w * NSEQ + s) * 64 + ln];
            MODS[((size_t)l * NSEQ + s) * MODW + n0 + ln] = sum + adab[(size_t)l * MODW + n0 + ln]; }
        __syncthreads();
    }
    __syncthreads();
}
DI void convert_layer(const Frame& F, int l, int w_idx, int w_cnt) {
    LAS float* scr = (LAS float*)(F.lds + F.wave * 16384);
    int it = w_idx;
#define CONVW(Wp, K_, N_, WTp, mode, count) { const int per = ((K_) / 64) * ((N_) / 32); const int tot = per * (count); \
    for (; it < tot; it += w_cnt) { const int mi = it / per; transpose_item((Wp) + (size_t)mi * (K_) * (N_), (K_), (N_), (WTp) + (size_t)mi * (K_) * (N_), (mode), scr, it % per, F.lane); } it -= tot; }
    CONVW(F.in[12] + (size_t)(2 * l) * DM * 2 * DFF, DM, 2 * DFF, (bf16_t*)(F.ws + WS_WI) + (size_t)(2 * l) * DM * 2 * DFF, 1, 2)
    CONVW(F.in[13] + (size_t)(2 * l) * DFF * DM, DFF, DM, (bf16_t*)(F.ws + WS_WO) + (size_t)(2 * l) * DFF * DM, 3, 2)
    const int kind = l % 3, j = l / 3;
    if (kind == 0) {
        CONVW(F.in[14] + (size_t)j * DM * 2 * DRNN, DM, 2 * DRNN, (bf16_t*)(F.ws + WS_WLI) + (size_t)j * DM * 2 * DRNN, 0, 1)
        CONVW(F.in[22] + (size_t)j * DRNN * DM, DRNN, DM, (bf16_t*)(F.ws + WS_WLO) + (size_t)j * DRNN * DM, 0, 1)
    } else if (kind == 1) {
        CONVW(F.in[23], 256, 256, (bf16_t*)(F.ws + WS_WP), 0, 4)
    } else {
        CONVW(F.in[26], DM, 3 * DM, (bf16_t*)(F.ws + WS_WQKV), 2, 1)
        CONVW(F.in[31], DM, DM, (bf16_t*)(F.ws + WS_WAO), 0, 1)
    }
#undef CONVW
}
DI void phase_p0(const Frame& F) {
    adaln_layer(F, 0, blockIdx.x, F.G);
    convert_layer(F, 0, F.gw, F.NGW);
    { float* spl = (float*)(F.ws + WS_SPL); const float* lam = F.in[21];
      for (int i = F.gtid; i < 2 * DRNN; i += F.GT) spl[i] = log1pf(expf(-lam[i])); }
    {
        bf16_t* WG = (bf16_t*)(F.ws + WS_WG);
        for (int i = F.gtid; i < 2 * 16 * 160 * 96; i += F.GT) { const int k = i % 96, n = (i / 96) % 160, jh = i / (96 * 160);
            float v = 0.f; if (k < 80) v = n < 80 ? F.in[17][((size_t)jh * 80 + k) * 80 + n] : F.in[19][((size_t)jh * 80 + k) * 80 + n - 80];
            WG[i] = (bf16_t)(cvt_pk_bf16(v, 0.f) & 0xffffu); }
    }
    {
        bf16_t* Kbs = (bf16_t*)(F.ws + WS_KBS); bf16_t* Vts = (bf16_t*)(F.ws + WS_VTS);
        const float* ck = F.in[7]; const float* cv = F.in[8];
        for (int i = F.gtid; i < 8 * TPS * 128; i += F.GT) { const int c8 = i & 127, pos = (i >> 7) % TPS, s = i / (TPS * 128);
            if (pos >= PAST && pos < KVS) continue;
            u32x4 w = (u32x4){0u, 0u, 0u, 0u};
            if (pos < PAST) { const float* p = ck + ((size_t)s * PAST + pos) * DM + c8 * 8; const f32x4 a = *(const f32x4*)p, b = *(const f32x4*)(p + 4);
                w.x = cvt_pk_bf16(a[0], a[1]); w.y = cvt_pk_bf16(a[2], a[3]); w.z = cvt_pk_bf16(b[0], b[1]); w.w = cvt_pk_bf16(b[2], b[3]); }
            *(u32x4*)(Kbs + ((size_t)s * TPS + pos) * DM + c8 * 8) = w; }
        for (int i = F.gtid; i < 8 * (TPS / 8) * DM; i += F.GT) { const int hd = i & 1023, p8 = (i >> 10) % (TPS / 8), s = i / ((TPS / 8) * DM); const int pos = p8 * 8;
            if (pos >= PAST && pos < KVS) continue;
            u32x4 w = (u32x4){0u, 0u, 0u, 0u};
            if (pos < PAST) { const float* p = cv + ((size_t)s * PAST + pos) * DM + hd;
                w.x = cvt_pk_bf16(p[0], p[DM]); w.y = cvt_pk_bf16(p[2 * DM], p[3 * DM]); w.z = cvt_pk_bf16(p[4 * DM], p[5 * DM]); w.w = cvt_pk_bf16(p[6 * DM], p[7 * DM]); }
            *(u32x4*)(Vts + ((size_t)s * DM + hd) * TPS + pos) = w; }
    }
}

template <bool XI32>
DI void phase_mod(const Frame& F, const void* xP, const void* xS, const float* g, const float* mods_l, int sidx, bool pool_out) {
    bf16_t* U = (bf16_t*)(F.ws + WS_U);
    for (int row = F.gw; row < NT; row += F.NGW) {
        const int seq = seq_of_row(row);
        f32x4 v[4]; float ss = 0.f;
        if constexpr (XI32) { const float* xr = (const float*)(row < NP ? xP : xS) + (size_t)row * DM + 4 * F.lane;
#pragma unroll
            for (int j = 0; j < 4; ++j) v[j] = *(const f32x4*)(xr + 256 * j);
        } else { const bf16_t* xr = (const bf16_t*)xP + (size_t)row * DM + 4 * F.lane;
#pragma unroll
            for (int j = 0; j < 4; ++j) { const u32x2 q = *(const u32x2*)(xr + 256 * j); v[j] = (f32x4){bflo(q.x), bfhi(q.x), bflo(q.y), bfhi(q.y)}; } }
#pragma unroll
        for (int j = 0; j < 4; ++j) ss += (v[j][0] * v[j][0] + v[j][1] * v[j][1]) + (v[j][2] * v[j][2] + v[j][3] * v[j][3]);
        const float rstd = 1.f / sqrtf(wave_sum(ss) * (1.f / DM) + EPS);
        const float* sh = mods_l + (size_t)seq * MODW + sidx * DM; const float* sc = sh + DM;
        const int pos = pos_of_row(row); const int tl = row < NP ? SEQ : DSEQ;
        float* po = nullptr;
        if (pool_out && pos >= tl - 15) po = row < NP ? F.out + O_PP + ((size_t)seq * 15 + (pos - (tl - 15))) * DM : F.out + O_PS + ((size_t)(seq - 2) * 15 + (pos - (tl - 15))) * DM;
        f32x4 g4v[4], s4v[4], c4v[4];
#pragma unroll
        for (int j = 0; j < 4; ++j) { const int col = 4 * F.lane + 256 * j; g4v[j] = *(const f32x4*)(g + col); s4v[j] = *(const f32x4*)(sh + col); c4v[j] = *(const f32x4*)(sc + col); }
#pragma unroll
        for (int j = 0; j < 4; ++j) { const int col = 4 * F.lane + 256 * j;
            const f32x4 g4 = g4v[j], s4 = s4v[j], c4 = c4v[j];
            const f32x4 y = (v[j] * rstd) * g4 * (1.f + c4) + s4;
            u32x2 w; w.x = cvt_pk_bf16(y[0], y[1]); w.y = cvt_pk_bf16(y[2], y[3]);
            *(u32x2*)(U + (size_t)row * DM + col) = w;
            if (po) *(f32x4*)(po + col) = y; }
    }
}

template <int NV, bool FIRST>
DI void conv_vec(float (&x)[NV], const bf16_t* XB, const float* cw, const float* cb, const float* cbuf, int row, int pos, int c) {
#pragma unroll
    for (int e4 = 0; e4 < NV / 4; ++e4) { const f32x4 b4 = *(const f32x4*)(cb + c + 4 * e4);
#pragma unroll
        for (int e = 0; e < 4; ++e) x[4 * e4 + e] = b4[e]; }
#pragma unroll
    for (int k = 0; k < 4; ++k) { const int i = pos + k; float v[NV];
        if (!FIRST || i >= 3) { const bf16_t* src = XB + (size_t)(row - 3 + k) * DRNN + c;
            if (NV == 8) { const u32x4 q = *(const u32x4*)src; v[0] = bflo(q.x); v[1] = bfhi(q.x); v[2] = bflo(q.y); v[3] = bfhi(q.y); v[4 % NV] = bflo(q.z); v[5 % NV] = bfhi(q.z); v[6 % NV] = bflo(q.w); v[7 % NV] = bfhi(q.w); }
            else { const u32x2 q = *(const u32x2*)src; v[0] = bflo(q.x); v[1] = bfhi(q.x); v[2] = bflo(q.y); v[3] = bfhi(q.y); }
        } else if (cbuf) {
#pragma unroll
            for (int e4 = 0; e4 < NV / 4; ++e4) { const f32x4 a4 = *(const f32x4*)(cbuf + (size_t)i * DRNN + c + 4 * e4);
#pragma unroll
                for (int e = 0; e < 4; ++e) v[4 * e4 + e] = a4[e]; }
        } else {
#pragma unroll
            for (int e = 0; e < NV; ++e) v[e] = 0.f;
        }
#pragma unroll
        for (int e4 = 0; e4 < NV / 4; ++e4) { const f32x4 w4 = *(const f32x4*)(cw + k * DRNN + c + 4 * e4);
#pragma unroll
            for (int e = 0; e < 4; ++e) x[4 * e4 + e] += w4[e] * v[4 * e4 + e]; } }
}
struct LruP { const bf16_t* WG; const bf16_t* XB; float* A; float* Bn; const float* cw; const float* cb; const float* gab; const float* gxb; const float* spl; };
constexpr int XCP = 84;
template <bool FIRST>
DI void lru_tile2(const LruP& P, const float* cbuf, int hb, int row, int pos, int fr, int fq, LAS float* xcs) {
    bf16x8 W[2][6]; f32x4 C[2][3];
#define LRU_PRELOAD(buf, nt_) do { const bf16_t* wp0 = P.WG + ((size_t)(hb * 160 + 16 * (nt_) + fr)) * 96 + 8 * fq; const bf16_t* wp1 = wp0 + 80 * 96; \
        asm volatile("" : "+v"(wp0), "+v"(wp1)); \
        _Pragma("unroll") for (int ks = 0; ks < 3; ++ks) { W[buf][ks] = *(const bf16x8*)(wp0 + 32 * ks); W[buf][3 + ks] = *(const bf16x8*)(wp1 + 32 * ks); } \
        const int ch_ = 80 * hb + 16 * (nt_) + 4 * fq; C[buf][0] = *(const f32x4*)(P.gab + ch_); C[buf][1] = *(const f32x4*)(P.gxb + ch_); C[buf][2] = *(const f32x4*)(P.spl + ch_); } while (0)
    LRU_PRELOAD(0, 0);
    bf16x8 xf[2][3];
#pragma unroll
    for (int tl = 0; tl < 2; ++tl)
#pragma unroll
        for (int ks = 0; ks < 3; ++ks) { const int kc = 32 * ks + 8 * fq; u32x4 w = (u32x4){0u, 0u, 0u, 0u};
            if (kc < 80) { float x[8];
                if (tl == 0) conv_vec<8, FIRST>(x, P.XB, P.cw, P.cb, cbuf, row, pos, 80 * hb + kc); else conv_vec<8, false>(x, P.XB, P.cw, P.cb, nullptr, row + 16, pos + 16, 80 * hb + kc);
                w.x = cvt_pk_bf16(x[0], x[1]); w.y = cvt_pk_bf16(x[2], x[3]); w.z = cvt_pk_bf16(x[4], x[5]); w.w = cvt_pk_bf16(x[6], x[7]);
                LAS float* xp = xcs + (tl * 16 + fr) * XCP + kc;
                *(LAS f32x4*)xp = (f32x4){x[0], x[1], x[2], x[3]}; *(LAS f32x4*)(xp + 4) = (f32x4){x[4], x[5], x[6], x[7]}; }
            xf[tl][ks] = __builtin_bit_cast(bf16x8, w); }
    asm volatile("s_waitcnt lgkmcnt(0)" ::: "memory");
#pragma unroll
    for (int nt = 0; nt < 5; ++nt) {
        const int cur = nt & 1;
        if (nt < 4) LRU_PRELOAD(cur ^ 1, nt + 1);
        f32x4 ar[2], ai[2];
        ar[0] = (f32x4){0.f, 0.f, 0.f, 0.f}; ar[1] = ar[0]; ai[0] = ar[0]; ai[1] = ar[0];
#pragma unroll
        for (int ks = 0; ks < 3; ++ks)
#pragma unroll
            for (int tl = 0; tl < 2; ++tl) { ar[tl] = __builtin_amdgcn_mfma_f32_16x16x32_bf16(W[cur][ks], xf[tl][ks], ar[tl], 0, 0, 0); ai[tl] = __builtin_amdgcn_mfma_f32_16x16x32_bf16(W[cur][3 + ks], xf[tl][ks], ai[tl], 0, 0, 0); }
        const int ch = 80 * hb + 16 * nt + 4 * fq; f32x4 av[2], bv[2], xc[2];
#pragma unroll
        for (int tl = 0; tl < 2; ++tl) xc[tl] = *(const LAS f32x4*)(xcs + (tl * 16 + fr) * XCP + 16 * nt + 4 * fq);
        const f32x4 ga4 = C[cur][0], gx4 = C[cur][1], sp4 = C[cur][2];
#pragma unroll
        for (int tl = 0; tl < 2; ++tl)
#pragma unroll
            for (int e = 0; e < 4; ++e) {
                const float r = sigmoidf_(ar[tl][e] + ga4[e]), ig = sigmoidf_(ai[tl][e] + gx4[e]);
                const float la = -8.f * r * sp4[e]; const float a = __expf(la);
                av[tl][e] = (la > -0.03f) ? -la * (1.f + la * (0.5f + la * (0.16666667f + la * 0.041666668f))) : 1.f - a;
                const float t = 2.f * la; const float om = (t > -0.06f) ? -t * (1.f + t * (0.5f + t * (0.16666667f + t * 0.041666668f))) : 1.f - a * a;
                bv[tl][e] = __builtin_amdgcn_sqrtf(om) * (ig * xc[tl][e]); }
#pragma unroll
        for (int tl = 0; tl < 2; ++tl) { u32x4 w;
            w.x = cvt_pk_bf16(av[tl][0], bv[tl][0]); w.y = cvt_pk_bf16(av[tl][1], bv[tl][1]); w.z = cvt_pk_bf16(av[tl][2], bv[tl][2]); w.w = cvt_pk_bf16(av[tl][3], bv[tl][3]);
            *(u32x4*)((unsigned*)P.A + (size_t)(row + 16 * tl) * DRNN + ch) = w; } }
#undef LRU_PRELOAD
    asm volatile("s_waitcnt lgkmcnt(0)" ::: "memory");
}
DI void phase_lru_gates(const Frame& F, int j) {
    LruP P;
    P.WG = (const bf16_t*)(F.ws + WS_WG) + (size_t)j * 16 * 160 * 96; P.XB = (const bf16_t*)(F.ws + WS_XB);
    P.A = (float*)(F.ws + WS_A); P.Bn = (float*)(F.ws + WS_BN);
    P.cw = F.in[15] + (size_t)j * 4 * DRNN; P.cb = F.in[16] + (size_t)j * DRNN;
    P.gab = F.in[18] + (size_t)j * DRNN; P.gxb = F.in[20] + (size_t)j * DRNN; P.spl = (const float*)(F.ws + WS_SPL) + (size_t)j * DRNN;
    const float* cst = F.in[5];
    const int fr = F.lane & 15, fq = F.lane >> 4;
    LAS float* xcs = (LAS float*)(F.lds + F.wave * 16384);
#pragma unroll 1
    for (int task = F.gw; task < (NT / 32) * 16; task += F.NGW) {
        asm volatile("" ::: "memory");
        const int hb = task & 15, tp = task >> 4; const int row = tp * 32 + fr; const int seq = seq_of_row(row), pos = pos_of_row(row);
        const bool first = pos_of_row(tp * 32) == 0;
        if (first) { const float* cbuf = row < NP ? nullptr : cst + ((size_t)j * 8 + (seq - 2)) * 3 * DRNN; lru_tile2<true>(P, cbuf, hb, row, pos, fr, fq, xcs); }
        else lru_tile2<false>(P, nullptr, hb, row, pos, fr, fq, xcs);
    }
}
DI void chunk_info(int ch, int& row0, int& len) { if (ch < 256) { row0 = ch * 64; len = 64; } else { row0 = NP + (ch - 256) * 32; len = 32; } }
DI void phase_lru_agg(const Frame& F) {
    const float* A = (const float*)(F.ws + WS_A); const float* Bn = (const float*)(F.ws + WS_BN); float* AG = (float*)(F.ws + WS_AGG);
    for (int it = F.gtid; it < 264 * DRNN; it += F.GT) { const int ch = it / DRNN, c = it % DRNN; int row0, len; chunk_info(ch, row0, len);
        float P = 1.f, S = 0.f; const unsigned* ab = (const unsigned*)A + (size_t)row0 * DRNN + c;
#pragma unroll 16
        for (int t = 0; t < len; ++t) { const unsigned w = ab[(size_t)t * DRNN]; const float at = 1.f - bflo(w), bt = bfhi(w); S = at * S + bt; P *= at; }
        AG[it] = P; AG[264 * DRNN + it] = S; }
}
DI void phase_lru_apply(const Frame& F, int j) {
    const float* A = (const float*)(F.ws + WS_A); const float* Bn = (const float*)(F.ws + WS_BN); const float* AG = (const float*)(F.ws + WS_AGG);
    const bf16_t* GB = (const bf16_t*)(F.ws + WS_GB); bf16_t* HG = (bf16_t*)(F.ws + WS_XB);
    for (int it = F.gtid; it < 264 * DRNN; it += F.GT) { const int ch = it / DRNN, c = it % DRNN; int row0, len; chunk_info(ch, row0, len);
        float h; int f0; bool lastc; float* ho;
        if (ch < 256) { f0 = ch & ~127; h = 0.f; lastc = (ch & 127) == 127; ho = F.out + O_HP + ((size_t)j * 2 + (ch >> 7)) * DRNN + c; }
        else { f0 = ch; h = F.in[4][((size_t)j * 8 + (ch - 256)) * DRNN + c]; lastc = true; ho = F.out + O_HS + ((size_t)j * 8 + (ch - 256)) * DRNN + c; }
#pragma unroll 8
        for (int cc = f0; cc < ch; ++cc) h = AG[cc * DRNN + c] * h + AG[264 * DRNN + cc * DRNN + c];
        const unsigned* ab = (const unsigned*)A + (size_t)row0 * DRNN + c; const bf16_t* gp = GB + (size_t)row0 * DRNN + c; bf16_t* hp = HG + (size_t)row0 * DRNN + c;
        unsigned wv[2][16]; bf16_t gv[2][16];
#pragma unroll
        for (int i = 0; i < 16; ++i) { wv[0][i] = ab[(size_t)i * DRNN]; gv[0][i] = gp[(size_t)i * DRNN]; }
#pragma unroll
        for (int blk = 0; blk < 4; ++blk) { const int t0 = 16 * blk, cur = blk & 1;
            if (t0 < len) {
                if (t0 + 16 < len) {
#pragma unroll
                    for (int i = 0; i < 16; ++i) { wv[cur ^ 1][i] = ab[(size_t)(t0 + 16 + i) * DRNN]; gv[cur ^ 1][i] = gp[(size_t)(t0 + 16 + i) * DRNN]; } }
#pragma unroll
                for (int i = 0; i < 16; ++i) { h = (1.f - bflo(wv[cur][i])) * h + bfhi(wv[cur][i]); hp[(size_t)(t0 + i) * DRNN] = (bf16_t)(cvt_pk_bf16(bf2f(gv[cur][i]) * h, 0.f) & 0xffffu); } } }
        if (lastc) *ho = h; }
}

template <int W>
DI void pool_fast(const bf16_t* U, bf16_t* Dp, int row, int col0) {
    u32x4 q[W];
#pragma unroll
    for (int k = 0; k < W; ++k) q[k] = *(const u32x4*)(U + (size_t)(row - k) * DM + col0);
    float s[8];
#pragma unroll
    for (int e = 0; e < 8; ++e) s[e] = 0.f;
#pragma unroll
    for (int k = 0; k < W; ++k) { s[0] += bflo(q[k].x); s[1] += bfhi(q[k].x); s[2] += bflo(q[k].y); s[3] += bfhi(q[k].y); s[4] += bflo(q[k].z); s[5] += bfhi(q[k].z); s[6] += bflo(q[k].w); s[7] += bfhi(q[k].w); }
    const float ic = 1.f / (float)W;
    u32x4 o; o.x = cvt_pk_bf16(s[0] * ic - bflo(q[0].x), s[1] * ic - bfhi(q[0].x)); o.y = cvt_pk_bf16(s[2] * ic - bflo(q[0].y), s[3] * ic - bfhi(q[0].y));
    o.z = cvt_pk_bf16(s[4] * ic - bflo(q[0].z), s[5] * ic - bfhi(q[0].z)); o.w = cvt_pk_bf16(s[6] * ic - bflo(q[0].w), s[7] * ic - bfhi(q[0].w));
    *(u32x4*)(Dp + (size_t)row * DM + col0) = o;
}
DI void phase_pool(const Frame& F) {
    const bf16_t* U = (const bf16_t*)(F.ws + WS_U); bf16_t* Dp = (bf16_t*)(F.ws + WS_DP); const float* sp = F.in[6];
    for (int it = F.gtid; it < NT * 128; it += F.GT) {
        const int row = ((it >> 8) << 1) | ((it >> 5) & 1), grp = (it >> 6) & 3, col0 = grp * 256 + (it & 31) * 8; const int w = 2 << grp;
        const int seq = seq_of_row(row), pos = pos_of_row(row);
        if (pos >= 15) { if (grp == 0) pool_fast<2>(U, Dp, row, col0); else if (grp == 1) pool_fast<4>(U, Dp, row, col0); else if (grp == 2) pool_fast<8>(U, Dp, row, col0); else pool_fast<16>(U, Dp, row, col0); continue; }
        float s[8], u0[8];
#pragma unroll
        for (int e = 0; e < 8; ++e) { s[e] = 0.f; u0[e] = 0.f; }
        const int cnt = row < NP ? (pos + 1 < w ? pos + 1 : w) : w;
        for (int k = 0; k < cnt; ++k) { const int p = pos - k;
            if (p >= 0) { const u32x4 q = *(const u32x4*)(U + (size_t)(row - k) * DM + col0);
                const float x0 = bflo(q.x), x1 = bfhi(q.x), x2 = bflo(q.y), x3 = bfhi(q.y), x4 = bflo(q.z), x5 = bfhi(q.z), x6 = bflo(q.w), x7 = bfhi(q.w);
                if (k == 0) { u0[0] = x0; u0[1] = x1; u0[2] = x2; u0[3] = x3; u0[4] = x4; u0[5] = x5; u0[6] = x6; u0[7] = x7; }
                s[0] += x0; s[1] += x1; s[2] += x2; s[3] += x3; s[4] += x4; s[5] += x5; s[6] += x6; s[7] += x7;
            } else { const float* q = sp + ((size_t)(seq - 2) * 15 + (15 + p)) * DM + col0; const f32x4 a = *(const f32x4*)q, b = *(const f32x4*)(q + 4);
                s[0] += a[0]; s[1] += a[1]; s[2] += a[2]; s[3] += a[3]; s[4] += b[0]; s[5] += b[1]; s[6] += b[2]; s[7] += b[3]; } }
        const float ic = 1.f / (float)cnt;
        u32x4 o; o.x = cvt_pk_bf16(s[0] * ic - u0[0], s[1] * ic - u0[1]); o.y = cvt_pk_bf16(s[2] * ic - u0[2], s[3] * ic - u0[3]);
        o.z = cvt_pk_bf16(s[4] * ic - u0[4], s[5] * ic - u0[5]); o.w = cvt_pk_bf16(s[6] * ic - u0[6], s[7] * ic - u0[7]);
        *(u32x4*)(Dp + (size_t)row * DM + col0) = o; }
}

constexpr int KPITCH = 144, VPITCH = 136, KBUF = 64 * KPITCH, VBUF = 128 * VPITCH;
constexpr int L_K = 0, L_V = 3 * KBUF, L_TAB = L_V + 3 * VBUF;
static_assert(L_TAB + 320 * 4 <= PTAB_OFF, "attention LDS");
DI int t5_bucket(int rel) {
    int ret = rel > 0 ? 16 : 0; const int n = rel < 0 ? -rel : rel;
    if (n < 8) return ret + n;
    int large = 8 + (int)(logf((float)n / 8.f) / 2.772588722239781f * 8.f); if (large > 15) large = 15;
    return ret + large;
}
struct AttnUnit { const bf16_t* Kb; const bf16_t* Vt; int tpad, kvlen, h, qrow0, qpos0, nq, ntiles; };
#define ATT_BAR() do { asm volatile("s_waitcnt lgkmcnt(0)" ::: "memory"); __builtin_amdgcn_s_barrier(); asm volatile("" ::: "memory"); } while (0)
DI void attn_unit(const Frame& F, const AttnUnit& u, float lam, float bound, float* park) {
    const int tid = F.tid, lane = F.lane, wave = F.wave, q = lane & 31, hi = lane >> 5;
    const bf16_t* Qb = (const bf16_t*)(F.ws + WS_QB); bf16_t* Ob = (bf16_t*)(F.ws + WS_OB);
    const float* relb = F.in[32];
    LAS unsigned char* lds = F.lds;
    LAS float* tab = (LAS float*)(lds + L_TAB);
    for (int i = tid; i < 319; i += 512) tab[i] = (relb[t5_bucket(i - 255) * 8 + u.h] - bound) * LOG2E;
    const float cfar = (relb[15 * 8 + u.h] - bound) * LOG2E;
    const bool active = 32 * wave < u.nq;
    const bool qvalid = active && (q < u.nq - 32 * wave);
    const int qposw = u.qpos0 + 32 * wave; const int qc = qposw >> 6;
    const int myq = qposw + q;
    const int klds = (tid >> 3) * KPITCH + (tid & 7) * 16, vlds = (tid >> 3) * VPITCH + (tid & 7) * 16;
    const GAS bf16_t* vg0 = (const GAS bf16_t*)(u.Vt + ((size_t)(u.h * 128 + (tid >> 3))) * u.tpad + (tid & 7) * 8);
    const size_t vrow64 = (size_t)64 * u.tpad;
    GAS float* pk = (GAS float*)(park + (size_t)tid * 64);
    const int nt = u.ntiles;
#pragma unroll 1
    for (int c = 0; c < 2; ++c) {
        const GAS bf16_t* kg0 = (const GAS bf16_t*)(u.Kb + (size_t)(tid >> 3) * DM + u.h * 128 + c * 64 + (tid & 7) * 8);
        bf16x8 qf[4];
        { const GAS bf16_t* qp = (const GAS bf16_t*)(Qb + (size_t)(u.qrow0 + 32 * wave + q) * DM + u.h * 128 + c * 64 + hi * 8);
#pragma unroll
          for (int ks = 0; ks < 4; ++ks) { u32x4 w = (u32x4){0u, 0u, 0u, 0u}; if (qvalid) w = *(const GAS u32x4*)(qp + ks * 16); qf[ks] = __builtin_bit_cast(bf16x8, w); } }
        u32x4 kA, vA0, vA1, kB, vB0, vB1;
#define ATT_LOAD(K_, V0_, V1_, kt) do { K_ = *(const GAS u32x4*)(kg0 + (size_t)(kt) * 64 * DM); V0_ = *(const GAS u32x4*)(vg0 + (kt) * 64); V1_ = *(const GAS u32x4*)(vg0 + vrow64 + (kt) * 64); } while (0)
#define ATT_WRITE(K_, V0_, V1_, b) do { *(LAS u32x4*)(lds + L_K + (b) * KBUF + klds) = K_; \
        *(LAS u32x2*)(lds + L_V + (b) * VBUF + vlds) = (u32x2){V0_.x, V0_.y}; *(LAS u32x2*)(lds + L_V + (b) * VBUF + vlds + 8) = (u32x2){V0_.z, V0_.w}; \
        *(LAS u32x2*)(lds + L_V + (b) * VBUF + vlds + 64 * VPITCH) = (u32x2){V1_.x, V1_.y}; *(LAS u32x2*)(lds + L_V + (b) * VBUF + vlds + 64 * VPITCH + 8) = (u32x2){V1_.z, V1_.w}; } while (0)
        f32x16 O[4];
#pragma unroll
        for (int d = 0; d < 4; ++d)
#pragma unroll
            for (int e = 0; e < 16; ++e) O[d][e] = 0.f;
        float lsum = 0.f;
#define ATT_VLD(dst, db, k2, b) do { const int vo = L_V + (b) * VBUF + (32 * (db) + q) * VPITCH + (16 * (k2) + 4 * hi) * 2; \
            const u32x2 lo = *(const LAS u32x2*)(lds + vo), hi2 = *(const LAS u32x2*)(lds + vo + 16); dst = __builtin_bit_cast(bf16x8, ((u32x4){lo.x, lo.y, hi2.x, hi2.y})); } while (0)
#define ATT_COMPUTE(kt, b) do { if (active && (kt) <= qc) { \
            const bool nearb = ((kt) >= qc - 2) || (64 * (kt) + 64 > u.kvlen); \
            bf16x8 P[4]; f32x16 S[2]; \
            { bf16x8 kf[2][4]; \
              _Pragma("unroll") for (int mb = 0; mb < 2; ++mb) _Pragma("unroll") for (int ks = 0; ks < 4; ++ks) \
                  kf[mb][ks] = *(const LAS bf16x8*)(lds + L_K + (b) * KBUF + (32 * mb + q) * KPITCH + ks * 32 + hi * 16); \
              const float sinit = nearb ? 0.f : cfar; \
              _Pragma("unroll") for (int mb = 0; mb < 2; ++mb) _Pragma("unroll") for (int e = 0; e < 16; ++e) S[mb][e] = sinit; \
              __builtin_amdgcn_s_setprio(1); \
              _Pragma("unroll") for (int ks = 0; ks < 4; ++ks) _Pragma("unroll") for (int mb = 0; mb < 2; ++mb) \
                  S[mb] = __builtin_amdgcn_mfma_f32_32x32x16_bf16(kf[mb][ks], qf[ks], S[mb], 0, 0, 0); \
              __builtin_amdgcn_s_setprio(0); } \
            bf16x8 v0[4], v1[4]; \
            _Pragma("unroll") for (int i = 0; i < 4; ++i) ATT_VLD(v0[i], 0, i, b); \
            __builtin_amdgcn_sched_barrier(0); \
            _Pragma("unroll") for (int mb = 0; mb < 2; ++mb) { \
                if (!nearb) { \
                    _Pragma("unroll") for (int e = 0; e < 16; ++e) { const float p = __builtin_amdgcn_exp2f(S[mb][e]); S[mb][e] = p; lsum += p; } \
                } else { \
                    _Pragma("unroll") for (int e = 0; e < 16; ++e) { const int kp = 64 * (kt) + 32 * mb + (e & 3) + 8 * (e >> 2) + 4 * hi; int idx = kp - myq + 255; idx = idx < 0 ? 0 : idx; \
                        float p = __builtin_amdgcn_exp2f(S[mb][e] + tab[idx]); if (kp >= u.kvlen) p = 0.f; S[mb][e] = p; lsum += p; } \
                } \
                _Pragma("unroll") for (int k1 = 0; k1 < 2; ++k1) { const int e0 = 8 * k1; u32x4 w; \
                    w.x = cvt_pk_bf16(S[mb][e0 + 0], S[mb][e0 + 1]); w.y = cvt_pk_bf16(S[mb][e0 + 2], S[mb][e0 + 3]); w.z = cvt_pk_bf16(S[mb][e0 + 4], S[mb][e0 + 5]); w.w = cvt_pk_bf16(S[mb][e0 + 6], S[mb][e0 + 7]); \
                    P[2 * mb + k1] = __builtin_bit_cast(bf16x8, w); } \
            } \
            __builtin_amdgcn_sched_barrier(0); \
            __builtin_amdgcn_s_setprio(1);     \
            _Pragma("unroll") for (int i = 0; i < 4; ++i) ATT_VLD(v1[i], 1, i, b); \
            _Pragma("unroll") for (int i = 0; i < 4; ++i) O[0] = __builtin_amdgcn_mfma_f32_32x32x16_bf16(v0[i], P[i], O[0], 0, 0, 0); \
            __builtin_amdgcn_sched_barrier(0); \
            _Pragma("unroll") for (int i = 0; i < 4; ++i) ATT_VLD(v0[i], 2, i, b); \
            _Pragma("unroll") for (int i = 0; i < 4; ++i) O[1] = __builtin_amdgcn_mfma_f32_32x32x16_bf16(v1[i], P[i], O[1], 0, 0, 0); \
            __builtin_amdgcn_sched_barrier(0); \
            _Pragma("unroll") for (int i = 0; i < 4; ++i) ATT_VLD(v1[i], 3, i, b); \
            _Pragma("unroll") for (int i = 0; i < 4; ++i) O[2] = __builtin_amdgcn_mfma_f32_32x32x16_bf16(v0[i], P[i], O[2], 0, 0, 0); \
            __builtin_amdgcn_sched_barrier(0); \
            _Pragma("unroll") for (int i = 0; i < 4; ++i) O[3] = __builtin_amdgcn_mfma_f32_32x32x16_bf16(v1[i], P[i], O[3], 0, 0, 0); \
            __builtin_amdgcn_s_setprio(0); \
        } } while (0)
        ATT_LOAD(kA, vA0, vA1, 0);
        if (nt > 1) ATT_LOAD(kB, vB0, vB1, 1);
        ATT_WRITE(kA, vA0, vA1, 0);
        ATT_BAR();
        int b0 = 0;
#pragma unroll 1
        for (int kt = 0; kt < nt; kt += 2) {
            const int b1 = b0 == 2 ? 0 : b0 + 1, b2 = b1 == 2 ? 0 : b1 + 1;
            if (kt + 2 < nt) ATT_LOAD(kA, vA0, vA1, kt + 2);
            ATT_COMPUTE(kt, b0);
            if (kt + 1 < nt) ATT_WRITE(kB, vB0, vB1, b1);
            ATT_BAR();
            if (kt + 1 >= nt) break;
            if (kt + 3 < nt) ATT_LOAD(kB, vB0, vB1, kt + 3);
            ATT_COMPUTE(kt + 1, b1);
            if (kt + 2 < nt) ATT_WRITE(kA, vA0, vA1, b2);
            ATT_BAR();
            b0 = b2;
        }
#undef ATT_LOAD
#undef ATT_WRITE
#undef ATT_COMPUTE
#undef ATT_VLD
        if (active) {
            const float lt = lsum + __shfl_xor(lsum, 32);
            if (c == 0) { const float i1 = 1.f / lt;
#pragma unroll
                for (int db = 0; db < 4; ++db)
#pragma unroll
                    for (int e4 = 0; e4 < 4; ++e4) *(GAS f32x4*)(pk + db * 16 + e4 * 4) = (f32x4){O[db][4 * e4] * i1, O[db][4 * e4 + 1] * i1, O[db][4 * e4 + 2] * i1, O[db][4 * e4 + 3] * i1};
            } else {
                const float i2 = lam / lt; float ss = 0.f;
#pragma unroll
                for (int db = 0; db < 4; ++db)
#pragma unroll
                    for (int e4 = 0; e4 < 4; ++e4) { const f32x4 pv = *(const GAS f32x4*)(pk + db * 16 + e4 * 4);
#pragma unroll
                        for (int e = 0; e < 4; ++e) { const float o = pv[e] - O[db][4 * e4 + e] * i2; O[db][4 * e4 + e] = o; ss += o * o; } }
                ss += __shfl_xor(ss, 32);
                const float rstd = (1.f - LAM_INIT) / sqrtf(ss * (1.f / 128.f) + EPS);
                const float* sg = F.in[30];
                if (qvalid) {
                    GAS bf16_t* orow = (GAS bf16_t*)(Ob + (size_t)(u.qrow0 + 32 * wave + q) * DM + u.h * 128);
#pragma unroll
                    for (int db = 0; db < 4; ++db)
#pragma unroll
                        for (int e4 = 0; e4 < 4; ++e4) { const int d = 32 * db + 8 * e4 + 4 * hi; const f32x4 g4 = *(const GAS f32x4*)((const GAS float*)sg + d);
                            u32x2 w; w.x = cvt_pk_bf16(O[db][4 * e4] * rstd * g4[0], O[db][4 * e4 + 1] * rstd * g4[1]); w.y = cvt_pk_bf16(O[db][4 * e4 + 2] * rstd * g4[2], O[db][4 * e4 + 3] * rstd * g4[3]);
                            *(GAS u32x2*)(orow + d) = w; }
                }
            }
        }
    }
}
DI void phase_attn(const Frame& F) {
    const float* lp = F.in[29];
    const float s1 = wave_sum(lp[F.lane] * lp[64 + F.lane]), s2 = wave_sum(lp[128 + F.lane] * lp[192 + F.lane]);
    const float lam = __expf(s1) - __expf(s2) + LAM_INIT;
    const float mq = wave_max(fabsf(F.in[27][F.lane])), mk = wave_max(fabsf(F.in[28][F.lane]));
    float mb = 0.f;
#pragma unroll
    for (int i = 0; i < 4; ++i) mb = fmaxf(mb, fabsf(F.in[32][F.lane + 64 * i]));
    mb = wave_max(mb);
    const float bound = 8.f * mq * mk * 1.02f + mb + 0.25f;
    const bf16_t* Kb = (const bf16_t*)(F.ws + WS_KB); const bf16_t* Vt = (const bf16_t*)(F.ws + WS_VT);
    const bf16_t* Kbs = (const bf16_t*)(F.ws + WS_KBS); const bf16_t* Vts = (const bf16_t*)(F.ws + WS_VTS);
    float* park = (float*)(F.ws + WS_BN) + (size_t)blockIdx.x * 64 * 512;
#pragma unroll 1
    for (int p = blockIdx.x; p < 256; p += F.G) {
        const int bh = p >> 4, qa = p & 15, b = bh >> 3, h = bh & 7;
#pragma unroll 1
        for (int half = 0; half < 2; ++half) { const int qb = half == 0 ? 31 - qa : qa;
            AttnUnit u; u.Kb = Kb + (size_t)b * SEQ * DM; u.Vt = Vt + (size_t)b * DM * SEQ; u.tpad = SEQ; u.kvlen = SEQ; u.h = h; u.qrow0 = b * SEQ + qb * 256; u.qpos0 = qb * 256; u.nq = 256; u.ntiles = 4 * (qb + 1);
            attn_unit(F, u, lam, bound, park); }
    }
#pragma unroll 1
    for (int p = blockIdx.x; p < 64; p += F.G) {
        const int s = p >> 3, h = p & 7;
        AttnUnit u; u.Kb = Kbs + (size_t)s * TPS * DM; u.Vt = Vts + (size_t)s * DM * TPS; u.tpad = TPS; u.kvlen = KVS; u.h = h; u.qrow0 = NP + 32 * s; u.qpos0 = PAST; u.nq = 32; u.ntiles = 17;
        attn_unit(F, u, lam, bound, park);
    }
}

#define XB_TMO      128
#define XB_XCNT(j)  (256  + 64 * (j))
#define XB_XSUB(j)  (1280 + 64 * (j))
#define XB_XGEN(j)  (2304 + 64 * (j))
#define XB_TOP      3328
#define XB_TOPGEN   3392
#define XB_SPIN_CAP (1u << 22)
DI unsigned xb_ld(unsigned* p)              { return __hip_atomic_load(p, __ATOMIC_RELAXED, __HIP_MEMORY_SCOPE_AGENT); }
DI unsigned xb_add(unsigned* p, unsigned v) { return __hip_atomic_fetch_add(p, v, __ATOMIC_RELAXED, __HIP_MEMORY_SCOPE_AGENT); }
DI unsigned xb_xcc_id() { return (unsigned)__builtin_amdgcn_s_getreg((3 << 11) | 20) & 0xFu; }
#define XB_SPIN(cond, bar) do { unsigned _sp = 0; while (cond) { __builtin_amdgcn_s_sleep(1); \
    if ((++_sp & 255u) == 0u) { if (xb_ld(&(bar)[XB_TMO])) break; if (_sp > XB_SPIN_CAP) { atomicAdd(&(bar)[XB_TMO], 1u); break; } } } } while (0)
struct XcdBarrier { unsigned* bar; unsigned x; volatile LAS unsigned* st; };
DI XcdBarrier xcd_barrier_post(unsigned* bar, volatile LAS unsigned* st) {
    XcdBarrier b; b.bar = bar; b.x = xb_xcc_id(); b.st = st;
    if (threadIdx.x == 0) (void)xb_add(&bar[XB_XCNT(b.x)], 1u);
    return b;
}
DI void xcd_barrier_complete(unsigned* bar, unsigned x, unsigned& nloc, unsigned& nx) {
    const unsigned G = gridDim.x * gridDim.y * gridDim.z;
    unsigned sum, cnt, mine, sp = 0u;
    for (;;) {
        sum = 0u; cnt = 0u; mine = 0u;
#pragma unroll
        for (unsigned j = 0; j < 16; ++j) { const unsigned c = xb_ld(&bar[XB_XCNT(j)]); sum += c; cnt += (c > 0u) ? 1u : 0u; mine = (j == x) ? c : mine; }
        if (sum == G) break;
        __builtin_amdgcn_s_sleep(1);
        if ((++sp & 255u) == 0u) { if (xb_ld(&bar[XB_TMO])) break; if (sp > XB_SPIN_CAP) { atomicAdd(&bar[XB_TMO], 1u); break; } }
    }
    nloc = mine > 0u ? mine : 1u; nx = cnt > 0u ? cnt : 1u;
}
DI void xcd_barrier(const XcdBarrier& b) {
    asm volatile("s_waitcnt vmcnt(0)" ::: "memory");
    __syncthreads();
    if (threadIdx.x == 0) {
        unsigned* bar = b.bar;
        __builtin_amdgcn_s_waitcnt(0);
        unsigned nloc = b.st[0], nx = b.st[1];
        if (nloc == 0u) { xcd_barrier_complete(bar, b.x, nloc, nx); b.st[0] = nloc; b.st[1] = nx; }
        const unsigned old = xb_add(&bar[XB_XSUB(b.x)], 1u);
        const unsigned gen = old / nloc;
        if (old + 1u == (gen + 1u) * nloc) {
            __builtin_amdgcn_fence(__ATOMIC_RELEASE, "agent");
            asm volatile("s_waitcnt vmcnt(0)" ::: "memory");
            const unsigned og = xb_add(&bar[XB_TOP], 1u);
            const unsigned tg = og / nx;
            if (og + 1u == (tg + 1u) * nx) xb_add(&bar[XB_TOPGEN], 1u);
            else XB_SPIN(xb_ld(&bar[XB_TOPGEN]) == tg, bar);
            __builtin_amdgcn_fence(__ATOMIC_ACQUIRE, "agent");
            xb_add(&bar[XB_XGEN(b.x)], 1u);
            asm volatile("s_waitcnt vmcnt(0)" ::: "memory");
        } else {
            XB_SPIN(xb_ld(&bar[XB_XGEN(b.x)]) == gen, bar);
            __builtin_amdgcn_fence(__ATOMIC_ACQUIRE, "agent");
            asm volatile("s_waitcnt vmcnt(0)" ::: "memory");
        }
    }
    __syncthreads();
}

__global__ void __launch_bounds__(512) fwd_megakernel(Params p) {
    extern __shared__ __attribute__((aligned(16))) unsigned char lds_raw[];
    cg::grid_group grid = cg::this_grid();
    Frame F;
    F.lds = (LAS unsigned char*)lds_raw; F.tid = threadIdx.x; F.lane = F.tid & 63; F.wave = __builtin_amdgcn_readfirstlane(F.tid >> 6);
    F.G = gridDim.x; F.gw = blockIdx.x * 8 + F.wave; F.NGW = F.G * 8; F.gtid = blockIdx.x * 512 + F.tid; F.GT = F.G * 512;
    F.in.lds = F.lds;
    volatile LAS unsigned* xst = (volatile LAS unsigned*)(F.lds + PTAB_OFF + 512);
    if (F.tid == 0) { xst[0] = 0u; xst[1] = 0u; }
    if (F.tid == 0) { LAS unsigned long long* pt = (LAS unsigned long long*)(F.lds + PTAB_OFF);
#pragma unroll
        for (int i = 0; i < 33; ++i) pt[i] = (unsigned long long)p.in[i];
        pt[33] = (unsigned long long)p.out; pt[34] = (unsigned long long)p.ws; }
    __syncthreads();
#define PH() do { asm volatile("" ::: "memory"); int t_ = threadIdx.x; asm volatile("" : "+v"(t_)); F.tid = t_; F.lane = t_ & 63; F.wave = __builtin_amdgcn_readfirstlane(t_ >> 6); \
        F.gw = blockIdx.x * 8 + F.wave; F.gtid = blockIdx.x * 512 + t_; F.out = (float*)F.in[33]; F.ws = (unsigned char*)F.in[34]; } while (0)
#define WSP(off) (F.ws + (off))
#define X_ ((bf16_t*)WSP(WS_X))
#define U_ ((const bf16_t*)WSP(WS_U))
#define H_ ((bf16_t*)WSP(WS_H))
#define MODSL ((const float*)WSP(WS_MODS) + (size_t)l * NSEQ * MODW)
#define NG (F.in[11] + (size_t)l * 3 * DM)
#ifdef PROBE_SYNC
#define SYNC() do { xcd_barrier(xbar); xcd_barrier(xbar); PH(); } while (0)
#else
#define SYNC() do { xcd_barrier(xbar); PH(); } while (0)
#endif
#ifdef PROBE_MOD
#define PMOD(T, ...) do { phase_mod<T>(__VA_ARGS__); phase_mod<T>(__VA_ARGS__); } while (0)
#else
#define PMOD(T, ...) phase_mod<T>(__VA_ARGS__)
#endif
    pg8::StaticOrder S;
#define RESID(XI, XO, SLAB_, xiP_, xiS_, xo_, gsc_, pb_, ps_) do { const void* r_xiP = (xiP_); const void* r_xiS = (xiS_); void* r_xo = (xo_); const float* r_pb = (pb_); const float* r_ps = (ps_); \
        { EpiResidT<XI, XO> E{r_xiP, r_xiS, r_xo, r_gate, gsc_, r_pb, r_ps}; pg8::gemm_phase(F.lds, g, S, E); } \
        small_gemm_resid<SLAB_, XI, XO>(F, g.A, g.lda, g.a_pn_off, g.Bt, g.K, r_xiS, r_xo, r_gate, gsc_, r_pb, r_ps); } while (0)
    PH();
    XcdBarrier xbar = xcd_barrier_post((unsigned*)F.ws, xst);
#ifndef NO_P0
    phase_p0(F);
#ifdef PROBE_P0
    __syncthreads(); phase_p0(F);
#endif
#endif
    grid.sync(); PH();

#pragma unroll 1
    for (int l = 0; l < 4; ++l) {
        const int kind = l % 3;
        if (l == 0) PMOD(true, F, F.in[0], F.in[1] - (size_t)NP * DM, NG, MODSL, 0, false); else PMOD(false, F, X_, X_, NG, MODSL, 0, false);
        SYNC();
        { pg8::Gemm g{U_, (const bf16_t*)WSP(WS_WI) + (size_t)(l * 2) * 2 * DFF * DM, NT, 2 * DFF, DM, DM, DM, 0, 128, 128}; S.init(NT, 2 * DFF, F.G, blockIdx.x);
          EpiSwiglu E{H_};
#ifndef NO_G1
          pg8::gemm_phase(F.lds, g, S, E);
#ifdef PROBE_G1
          pg8::gemm_phase(F.lds, g, S, E);
#endif
#endif
          { const int tail0 = ((NT / 256) * (2 * DFF / 256)) % F.G;
            if (l < 3 && (int)blockIdx.x >= tail0) { const int bi = blockIdx.x - tail0, bc = F.G - tail0;
                adaln_layer(F, l + 1, bi, bc); convert_layer(F, l + 1, 2 * (bi * 8 + F.wave), 2 * bc * 8); } }
        }
        SYNC();
        { pg8::Gemm g{H_, (const bf16_t*)WSP(WS_WO) + (size_t)(l * 2) * DM * DFF, NP, DM, DFF, 64, 64, 0, (size_t)NT * 128, (size_t)DM * 128}; S.init(NP, DM, F.G, blockIdx.x);
          const float* r_gate = MODSL + 2 * DM;
          if (l == 0) RESID(true, false, true, F.in[0], F.in[1] - (size_t)NP * DM, X_, 0.5f, nullptr, nullptr); else RESID(false, false, true, X_, X_, X_, 0.5f, nullptr, nullptr);
        }
        SYNC();
        PMOD(false, F, X_, X_, NG + DM, MODSL, 3, kind == 1);
        SYNC();
        if (kind == 0) {
            const int j = l / 3;
            { pg8::Gemm g{U_, (const bf16_t*)WSP(WS_WLI) + (size_t)j * 2 * DRNN * DM, NT, 2 * DRNN, DM, DM, DM, 0, 128, 128}; S.init(NT, 2 * DRNN, F.G, blockIdx.x);
              EpiLruIn E{(bf16_t*)WSP(WS_GB), (bf16_t*)WSP(WS_XB), F.out + O_CP + (size_t)j * 2 * 3 * DRNN, F.out + O_CS + (size_t)j * 8 * 3 * DRNN};
#ifndef NO_G3
              pg8::gemm_phase(F.lds, g, S, E);
#endif
            }
            SYNC();
#ifndef NO_LRUG
            phase_lru_gates(F, j);
#ifdef PROBE_LRUG
            phase_lru_gates(F, j);
#endif
#endif
            SYNC();
            phase_lru_agg(F);
#ifdef PROBE_LRUA
            phase_lru_agg(F);
#endif
            SYNC();
            phase_lru_apply(F, j);
#ifdef PROBE_LRUP
            phase_lru_apply(F, j);
#endif
            SYNC();
            { pg8::Gemm g{(const bf16_t*)WSP(WS_XB), (const bf16_t*)WSP(WS_WLO) + (size_t)j * DM * DRNN, NP, DM, DRNN, DRNN, DRNN, 0, 128, 128}; S.init(NP, DM, F.G, blockIdx.x);
          const float* r_gate = MODSL + 5 * DM;
          RESID(false, false, false, X_, X_, X_, 1.f, nullptr, nullptr);
            }
        } else if (kind == 1) {
            phase_pool(F);
#ifdef PROBE_POOL
            phase_pool(F);
#endif
            SYNC();
            { pg8::Gemm g{(const bf16_t*)WSP(WS_DP), (const bf16_t*)WSP(WS_WP), NP, DM, 256, DM, 256, 256, 128, 128}; S.init(NP, DM, F.G, blockIdx.x);
          const float* r_gate = MODSL + 5 * DM;
          RESID(false, false, false, X_, X_, X_, 1.f, F.in[24], F.in[25]);
            }
        } else {
            { pg8::Gemm g{U_, (const bf16_t*)WSP(WS_WQKV), NT, 3 * DM, DM, DM, DM, 0, 128, 128}; S.init(NT, 3 * DM, F.G, blockIdx.x);
              EpiQKV E{(bf16_t*)WSP(WS_QB), (bf16_t*)WSP(WS_KB), (bf16_t*)WSP(WS_VT), (bf16_t*)WSP(WS_KBS), (bf16_t*)WSP(WS_VTS), F.out, F.in[27], F.in[28]};
#ifndef NO_G4
              pg8::gemm_phase(F.lds, g, S, E);
#endif
            }
            SYNC();
#ifndef NO_ATTN
            phase_attn(F);
#ifdef PROBE_ATTN
            phase_attn(F);
#endif
#endif
            SYNC();
            { pg8::Gemm g{(const bf16_t*)WSP(WS_OB), (const bf16_t*)WSP(WS_WAO), NP, DM, DM, DM, DM, 0, 128, 128}; S.init(NP, DM, F.G, blockIdx.x);
          const float* r_gate = MODSL + 5 * DM;
          RESID(false, false, false, X_, X_, X_, 1.f, nullptr, nullptr);
            }
        }
        SYNC();
        PMOD(false, F, X_, X_, NG + 2 * DM, MODSL, 6, false);
        SYNC();
        { pg8::Gemm g{U_, (const bf16_t*)WSP(WS_WI) + (size_t)(l * 2 + 1) * 2 * DFF * DM, NT, 2 * DFF, DM, DM, DM, 0, 128, 128}; S.init(NT, 2 * DFF, F.G, blockIdx.x);
          EpiSwiglu E{H_};
#ifndef NO_G1
          pg8::gemm_phase(F.lds, g, S, E);
#ifdef PROBE_G1
          pg8::gemm_phase(F.lds, g, S, E);
#endif
#endif
                  { const int tail0 = ((NT / 256) * (2 * DFF / 256)) % F.G;
            if (l < 3 && (int)blockIdx.x >= tail0) { const int bi = blockIdx.x - tail0, bc = F.G - tail0;
                convert_layer(F, l + 1, 2 * (bi * 8 + F.wave) + 1, 2 * bc * 8); } }
        }
        SYNC();
        { pg8::Gemm g{H_, (const bf16_t*)WSP(WS_WO) + (size_t)(l * 2 + 1) * DM * DFF, NP, DM, DFF, 64, 64, 0, (size_t)NT * 128, (size_t)DM * 128}; S.init(NP, DM, F.G, blockIdx.x);
          const float* r_gate = MODSL + 8 * DM;
          if (l == 3) RESID(false, true, true, X_, X_, F.out + O_Y, 0.5f, nullptr, nullptr); else RESID(false, false, true, X_, X_, X_, 0.5f, nullptr, nullptr);
        }
        SYNC();
    }
}

extern "C" void kernel_launch(void* const* d_in, const int* in_sizes, int n_in, void* d_out, int out_size, void* d_ws, size_t ws_size, hipStream_t stream) {
    static int grid = 0;
    if (grid == 0) {
        if (n_in != 33 || out_size != (int)O_END || ws_size < WS_END) { fprintf(stderr, "kernel_launch: unexpected shapes (n_in %d out %d ws %zu)\n", n_in, out_size, ws_size); grid = -1; return; }
        int dev = 0, cus = 0, per_cu = 0;
        (void)hipGetDevice(&dev); (void)hipDeviceGetAttribute(&cus, hipDeviceAttributeMultiprocessorCount, dev);
        (void)hipFuncSetAttribute((const void*)fwd_megakernel, hipFuncAttributeMaxDynamicSharedMemorySize, LDS_BYTES);
        (void)hipOccupancyMaxActiveBlocksPerMultiprocessor(&per_cu, (const void*)fwd_megakernel, 512, LDS_BYTES);
        if (per_cu < 1) { fprintf(stderr, "kernel_launch: occupancy query says %d blocks/CU\n", per_cu); per_cu = 1; }
        (void)hipGetLastError();
        grid = cus;
    }
    if (grid < 0) return;
    (void)hipMemsetAsync(d_ws, 0, 65536, stream);
    Params p{};
    for (int i = 0; i < 33; ++i) p.in[i] = (const float*)d_in[i];
    p.out = (float*)d_out; p.ws = (unsigned char*)d_ws;
    void* args[] = {&p};
    hipError_t e = hipLaunchCooperativeKernel((const void*)fwd_megakernel, dim3(grid), dim3(512), args, LDS_BYTES, stream);
    if (e != hipSuccess) fprintf(stderr, "cooperative launch failed: %s (grid %d)\n", hipGetErrorString(e), grid);
}
```
